# Optimizing an MI355X kernel written in HIP

```python
import jax, jax.numpy as jnp
from jax import lax
import numpy as np

D_MODEL = 1024
BATCH = 2
SEQ = 16384
DEPTH = 4

D_MIX = D_MODEL
CONV_CH = D_MIX // 2
HGRN_W = D_MIX - CONV_CH
CONV_GROUPS = 8
CONV_K = 3
HGRN_EXPAND = 128
HGRN_HEADS = HGRN_W // HGRN_EXPAND
HGRN_DK = HGRN_EXPAND
HGRN_DV = HGRN_W // HGRN_HEADS
CHUNK = 64
D_IN_PROJ = 3 * CONV_CH + 4 * HGRN_W
SPLITS = (CONV_CH, 2 * CONV_CH, 3 * CONV_CH, 3 * CONV_CH + HGRN_W, 3 * CONV_CH + 2 * HGRN_W, 3 * CONV_CH + 3 * HGRN_W)
N_EXPERTS = 32
TOP_K = 4
D_EXPERT = D_MODEL
SWIGLU_LIMIT = 7.0
SWIGLU_ALPHA = 1.702
MOE_BLOCK = 256
RMS_EPS = 1e-6

kernel_name = 'hybrid_conv_hgrn2_moe_adaln'


def rms_norm(x, g):
    xf = x.astype(jnp.float32)
    y = xf * lax.rsqrt(jnp.mean(xf * xf, axis=-1, keepdims=True) + RMS_EPS)
    return (y * g.astype(jnp.float32)).astype(x.dtype)


def modulate(xn, shift, scale):
    return xn * (1 + scale[:, None, :]) + shift[:, None, :]


def short_conv(u, w):
    ch = u.shape[-1]
    return lax.conv_general_dilated(u, w.reshape(CONV_K, 1, ch).astype(u.dtype), window_strides=(1,), padding=[(CONV_K - 1, 0)], dimension_numbers=('NWC', 'WIO', 'NWC'), feature_group_count=ch)


def hgrn2_scan(q, k, v, log_f):
    bsz, seq, h, dk = q.shape
    dv = v.shape[-1]
    n = seq // CHUNK

    def to_chunks(t):
        return t.reshape(bsz, n, CHUNK, h, t.shape[-1]).transpose(1, 0, 3, 2, 4)

    causal = jnp.tril(jnp.ones((CHUNK, CHUNK), dtype=bool))

    def step(state, inp):
        qc, kc, vc, gc = inp
        G = jnp.cumsum(gc, axis=2)
        diff = G[:, :, :, None, :] - G[:, :, None, :, :]
        decay = jnp.exp(jnp.where(causal[:, :, None], diff, -jnp.inf))
        scores = jnp.einsum('bhtd,bhsd,bhtsd->bhts', qc, kc, decay)
        o = jnp.einsum('bhts,bhsv->bhtv', scores, vc) + jnp.einsum('bhtd,bhdv->bhtv', qc * jnp.exp(G), state)
        G_last = G[:, :, -1:, :]
        state = jnp.exp(G_last[:, :, 0, :])[..., None] * state + jnp.einsum('bhsd,bhsv->bhdv', kc * jnp.exp(G_last - G), vc)
        return state, o

    init = jnp.zeros((bsz, h, dk, dv), jnp.float32)
    _, o = lax.scan(step, init, (to_chunks(q), to_chunks(k), to_chunks(v), to_chunks(log_f)))
    return o.transpose(1, 0, 3, 2, 4).reshape(bsz, seq, h, dv)


def token_mixer(hn, w_in, conv_w, conv_norm_g, lb, hgrn_norm_g, w_out):
    bsz, seq, _ = hn.shape
    proj = hn @ w_in
    cb, cc, ch, q, f, i, og = jnp.split(proj, SPLITS, axis=-1)
    yc = cb * short_conv(cc * ch, conv_w)
    yc = rms_norm(yc.reshape(bsz, seq, CONV_GROUPS, CONV_CH // CONV_GROUPS), conv_norm_g.reshape(CONV_GROUPS, -1)).reshape(bsz, seq, CONV_CH)
    lbf = lb.astype(jnp.float32)
    qf = jax.nn.silu(q.astype(jnp.float32)).reshape(bsz, seq, HGRN_HEADS, HGRN_DK)
    log_f = jnp.logaddexp(jnp.log(lbf), jnp.log1p(-lbf) + jax.nn.log_sigmoid(f.astype(jnp.float32)))
    log_f = log_f.reshape(bsz, seq, HGRN_HEADS, HGRN_DK)
    kf = -jnp.expm1(log_f)
    vf = i.astype(jnp.float32).reshape(bsz, seq, HGRN_HEADS, HGRN_DV)
    oh = hgrn2_scan(qf, kf, vf, log_f).astype(hn.dtype)
    oh = rms_norm(oh, hgrn_norm_g.reshape(HGRN_HEADS, HGRN_DV)).reshape(bsz, seq, HGRN_W)
    oh = oh * jax.nn.silu(og)
    return jnp.concatenate([yc, oh], axis=-1) @ w_out


def moe(h, w_r, b_r, w_gu, b_gu, w_dn, b_dn):
    bsz, seq, d = h.shape
    n_tok = bsz * seq
    xt = h.reshape(n_tok, d)
    logits = (xt @ w_r + b_r).astype(jnp.float32)
    top_val, top_idx = lax.top_k(logits, TOP_K)
    gates = jax.nn.softmax(top_val, axis=-1).astype(h.dtype)
    n_assign = n_tok * TOP_K
    e_flat = top_idx.reshape(n_assign)
    tok_flat = jnp.broadcast_to(jnp.arange(n_tok, dtype=jnp.int32)[:, None], (n_tok, TOP_K)).reshape(n_assign)
    g_flat = gates.reshape(n_assign)
    order = jnp.argsort(e_flat)
    e_s, tok_s, g_s = e_flat[order], tok_flat[order], g_flat[order]
    counts = jnp.bincount(e_flat, length=N_EXPERTS)
    starts = jnp.cumsum(counts) - counts
    padded = ((counts + MOE_BLOCK - 1) // MOE_BLOCK) * MOE_BLOCK
    pends = jnp.cumsum(padded)
    pstarts = pends - padded
    pos = pstarts[e_s] + jnp.arange(n_assign, dtype=jnp.int32) - starts[e_s]
    n_blocks = -(-n_assign // MOE_BLOCK) + N_EXPERTS
    p_rows = n_blocks * MOE_BLOCK
    pad_tok = jnp.full((p_rows,), n_tok, dtype=jnp.int32).at[pos].set(tok_s)
    pad_gate = jnp.zeros((p_rows,), h.dtype).at[pos].set(g_s)
    block_eid = jnp.minimum(jnp.searchsorted(pends, jnp.arange(n_blocks, dtype=pends.dtype) * MOE_BLOCK, side='right'), N_EXPERTS - 1)
    x_pad = jnp.concatenate([xt, jnp.zeros((1, d), xt.dtype)], axis=0)

    def expert_block(args):
        tok, gate, e = args
        hgu = x_pad[tok] @ w_gu[e] + b_gu[e]
        a, b = jnp.split(hgu, 2, axis=-1)
        a = jnp.minimum(a, SWIGLU_LIMIT)
        b = jnp.clip(b, -SWIGLU_LIMIT, SWIGLU_LIMIT)
        act = a * jax.nn.sigmoid(SWIGLU_ALPHA * a) * (b + 1)
        return (act @ w_dn[e] + b_dn[e]) * gate[:, None]

    yb = lax.map(expert_block, (pad_tok.reshape(n_blocks, MOE_BLOCK), pad_gate.reshape(n_blocks, MOE_BLOCK), block_eid))
    out = jax.ops.segment_sum(yb.reshape(p_rows, d), pad_tok, num_segments=n_tok + 1)[:n_tok]
    return out.reshape(bsz, seq, d)


def setup_inputs(seed: int = 0) -> dict:
    key = jax.random.key(seed)
    ks = jax.random.split(key, 19)
    nrm = jax.random.normal
    D, E, F = D_MODEL, N_EXPERTS, D_EXPERT
    return {
        'x': nrm(ks[0], (BATCH, SEQ, D), jnp.float32),
        'c': nrm(ks[1], (BATCH, D), jnp.float32),
        'w_ada': nrm(ks[2], (DEPTH, D, 6 * D), jnp.float32) * (0.5 * D ** -0.5),
        'b_ada': nrm(ks[3], (DEPTH, 6 * D), jnp.float32) * 0.02,
        'norm1_g': 1.0 + 0.02 * nrm(ks[4], (DEPTH, D), jnp.float32),
        'norm2_g': 1.0 + 0.02 * nrm(ks[5], (DEPTH, D), jnp.float32),
        'w_in': nrm(ks[6], (DEPTH, D, D_IN_PROJ), jnp.float32) * D ** -0.5,
        'conv_w': nrm(ks[7], (DEPTH, CONV_K, CONV_CH), jnp.float32) * CONV_K ** -0.5,
        'conv_norm_g': 1.0 + 0.02 * nrm(ks[8], (DEPTH, CONV_CH), jnp.float32),
        'lower_bounds': 0.5 * nrm(ks[9], (DEPTH, HGRN_W), jnp.float32),
        'hgrn_norm_g': 1.0 + 0.02 * nrm(ks[10], (DEPTH, HGRN_W), jnp.float32),
        'w_out': nrm(ks[11], (DEPTH, D_MIX, D), jnp.float32) * D_MIX ** -0.5,
        'w_router': nrm(ks[12], (DEPTH, D, E), jnp.float32) * D ** -0.5,
        'b_router': nrm(ks[13], (DEPTH, E), jnp.float32) * 0.01,
        'w_gu': nrm(ks[14], (DEPTH, E, D, 2 * F), jnp.float32) * D ** -0.5,
        'b_gu': nrm(ks[15], (DEPTH, E, 2 * F), jnp.float32) * 0.02,
        'w_down': nrm(ks[16], (DEPTH, E, F, D), jnp.float32) * F ** -0.5,
        'b_down': nrm(ks[17], (DEPTH, E, D), jnp.float32) * 0.02,
        'final_g': 1.0 + 0.02 * nrm(ks[18], (D,), jnp.float32),
    }


def reference(x, c, w_ada, b_ada, norm1_g, norm2_g, w_in, conv_w, conv_norm_g, lower_bounds, hgrn_norm_g, w_out, w_router, b_router, w_gu, b_gu, w_down, b_down, final_g):
    lb_all = jnp.cumsum(jax.nn.softmax(lower_bounds.astype(jnp.float32), axis=0), axis=0)
    lb_all = lb_all - lb_all[0]
    c_act = jax.nn.silu(c)
    for l in range(DEPTH):
        ada = c_act @ w_ada[l] + b_ada[l]
        sh1, sc1, g1, sh2, sc2, g2 = jnp.split(ada, 6, axis=-1)
        hn = modulate(rms_norm(x, norm1_g[l]), sh1, sc1)
        x = x + g1[:, None, :] * token_mixer(hn, w_in[l], conv_w[l], conv_norm_g[l], lb_all[l], hgrn_norm_g[l], w_out[l])
        hn = modulate(rms_norm(x, norm2_g[l]), sh2, sc2)
        x = x + g2[:, None, :] * moe(hn, w_router[l], b_router[l], w_gu[l], b_gu[l], w_down[l], b_down[l])
    return rms_norm(x, final_g)
```

```cpp
#include <hip/hip_runtime.h>
#include <cstdio>
#include <cstdint>

#ifndef MK_SPLIT
#define MK_SPLIT 0
#endif
#ifndef PROBE_REP
#define PROBE_REP 0
#endif
#define REPS(k) (1 + ((PROBE_REP >> (k)) & 1))

#define GAS __attribute__((address_space(1)))
#define LAS __attribute__((address_space(3)))
typedef unsigned short bf16_t;
typedef short bf16x8 __attribute__((ext_vector_type(8)));
typedef float f32x4 __attribute__((ext_vector_type(4)));
typedef float f32x2 __attribute__((ext_vector_type(2)));
typedef unsigned u32x4 __attribute__((ext_vector_type(4)));
typedef unsigned u32x2 __attribute__((ext_vector_type(2)));

constexpr int D = 1024, NBATCH = 2, SEQ = 16384, NTOK = NBATCH * SEQ, DEPTH = 4;
constexpr int NPROJ = 3584, NE = 32, TOPK = 4, NASSIGN = NTOK * TOPK;
constexpr int CHUNK = 64, NCHUNK = SEQ / CHUNK, NHEAD = 4, DK = 128;
constexpr int NUNIT = NBATCH * NHEAD * NCHUNK;
constexpr int MAXMBLK = NASSIGN / 256 + NE;
constexpr int PROWS = MAXMBLK * 256;
constexpr float RMS_EPS = 1e-6f;
constexpr float WGU_SCALE = 32.0f;
constexpr int NPO = 3072;
constexpr int PC_U = 0, PC_CB = 512, PC_Q = 1024, PC_F = 1536, PC_I = 2048, PC_OG = 2560;
__host__ __device__ constexpr int win_row(int n) { return n < 512 ? 1024 + n : n < 1024 ? 256 * ((n - 512) >> 7) + ((n - 512) & 127) : n < 1536 ? 256 * ((n - 1024) >> 7) + 128 + ((n - 1024) & 127) : n; }

constexpr size_t MiB = 1u << 20;
constexpr size_t WS_CTL = 0, CTL_ZERO_BYTES = 1 * MiB;
constexpr size_t WS_ADA = 1 * MiB;
constexpr size_t WS_LB = 1 * MiB + 512 * 1024;
constexpr size_t WS_RB = 1 * MiB + 768 * 1024;
constexpr size_t WS_WL = 1121 * MiB;
constexpr size_t WS_WIN = 2 * MiB;
constexpr size_t WS_WOUT = 30 * MiB;
constexpr size_t WS_WGU = 38 * MiB;
constexpr size_t WS_WDN = 550 * MiB;
constexpr size_t WS_HN = 806 * MiB;
constexpr size_t WS_PROJ = 872 * MiB;
constexpr size_t WS_U = 1096 * MiB;
constexpr size_t WS_CARRY = 1112 * MiB;
constexpr size_t WS_SEGD = 1120 * MiB;
constexpr size_t WS_DEC = 1224 * MiB;
constexpr size_t WS_ST8 = 1321 * MiB;
constexpr size_t WS_S = 1225 * MiB;
constexpr size_t WS_Y = 1289 * MiB;
constexpr size_t WS_X0 = 1353 * MiB;
constexpr size_t WS_X1 = 1481 * MiB;
constexpr size_t WS_LISTA = 1609 * MiB;
constexpr size_t WS_HN8 = 1720 * MiB;
constexpr size_t WS_ACT = 1881 * MiB;
constexpr size_t WS_SLOT = 2153 * MiB;
constexpr size_t WS_PADSLOT = 2409 * MiB;
constexpr size_t WS_PADGATE = 2410 * MiB;
constexpr size_t WS_TOKE = 2411 * MiB;
constexpr size_t WS_TOKPOS = 2411 * MiB + 512 * 1024;
constexpr size_t WS_TOKGATE = 2412 * MiB;
constexpr size_t WS_END = 2413 * MiB;
constexpr int CW_CNT = 1024;
constexpr int CW_BAR = 4096;
constexpr int CW_QUEUE = 8192;

constexpr int RING_BYTES = 131072;
constexpr int MISC_OFF = 139264;
constexpr int BIAS_OFF = 131072;
constexpr int IDX_OFF = 147456;
constexpr int MAXU = 32;
constexpr int LDS_BYTES = 163840;
constexpr int MS_BAR = 0;
constexpr int MS_PSTART = 64;
constexpr int MS_CNT = 256;
constexpr int MS_LCNT = 512;
constexpr int MS_GBASE = 768;
constexpr int MS_BLKE = 1024;
constexpr int MS_LE = 2048;
constexpr int MS_LPOS = 4096;
constexpr int MS_NM = 6144;

__device__ __forceinline__ unsigned pk2(float lo, float hi) { unsigned r; asm("v_cvt_pk_bf16_f32 %0, %1, %2" : "=v"(r) : "v"(lo), "v"(hi)); return r; }
__device__ __forceinline__ unsigned f2bf(float f) { return pk2(f, 0.f) & 0xffffu; }
__device__ __forceinline__ unsigned bf_rne(float f) { unsigned u = __float_as_uint(f); u += 0x7fffu + ((u >> 16) & 1u); return u >> 16; }
__device__ __forceinline__ float frcp(float x) { return __builtin_amdgcn_rcpf(x); }
__device__ __forceinline__ f32x2 v2exp2(f32x2 x) { return (f32x2){__builtin_amdgcn_exp2f(x.x), __builtin_amdgcn_exp2f(x.y)}; }
__device__ __forceinline__ f32x2 v2log2(f32x2 x) { return (f32x2){__builtin_amdgcn_logf(x.x), __builtin_amdgcn_logf(x.y)}; }
__device__ __forceinline__ f32x2 v2rcp(f32x2 x) { return (f32x2){__builtin_amdgcn_rcpf(x.x), __builtin_amdgcn_rcpf(x.y)}; }
__device__ __forceinline__ f32x2 v2bf(unsigned w) { return (f32x2){__uint_as_float(w << 16), __uint_as_float(w & 0xffff0000u)}; }
__device__ __forceinline__ unsigned pk2v(f32x2 v) { return pk2(v.x, v.y); }
constexpr float LOG2E = 1.4426950408889634f;
__device__ __forceinline__ float frsq(float x) { return __builtin_amdgcn_rsqf(x); }
__device__ __forceinline__ float bflo(unsigned w) { return __uint_as_float(w << 16); }
__device__ __forceinline__ float bfhi(unsigned w) { return __uint_as_float(w & 0xffff0000u); }
template <int CTRL> __device__ __forceinline__ float dpp_f(float v) { return __int_as_float(__builtin_amdgcn_update_dpp(0, __float_as_int(v), CTRL, 0xf, 0xf, false)); }
template <int CTRL> __device__ __forceinline__ int dpp_i(int v) { return __builtin_amdgcn_update_dpp(0, v, CTRL, 0xf, 0xf, false); }
__device__ __forceinline__ float row16_sum(float v) {
    v += dpp_f<0x128>(v); v += dpp_f<0x124>(v); v += dpp_f<0x122>(v); v += dpp_f<0x121>(v); return v; }
__device__ __forceinline__ float oct_sum(float v) {
    v += dpp_f<0xB1>(v); v += dpp_f<0x4E>(v); v += dpp_f<0x141>(v); return v; }
__device__ __forceinline__ float wave_sum(float v) { v = row16_sum(v); v += __shfl_xor(v, 16); v += __shfl_xor(v, 32); return v; }
__device__ __forceinline__ void unpack8(const u32x4 w, float (&o)[8]) { o[0] = bflo(w.x); o[1] = bfhi(w.x); o[2] = bflo(w.y); o[3] = bfhi(w.y); o[4] = bflo(w.z); o[5] = bfhi(w.z); o[6] = bflo(w.w); o[7] = bfhi(w.w); }
__device__ __forceinline__ u32x4 pack8(const float (&o)[8]) { u32x4 w; w.x = pk2(o[0], o[1]); w.y = pk2(o[2], o[3]); w.z = pk2(o[4], o[5]); w.w = pk2(o[6], o[7]); return w; }
__device__ __forceinline__ u32x2 pack8_fp8(const float (&o)[8]) { int lo = 0, hi = 0;
    lo = __builtin_amdgcn_cvt_pk_fp8_f32(o[0], o[1], lo, false); lo = __builtin_amdgcn_cvt_pk_fp8_f32(o[2], o[3], lo, true);
    hi = __builtin_amdgcn_cvt_pk_fp8_f32(o[4], o[5], hi, false); hi = __builtin_amdgcn_cvt_pk_fp8_f32(o[6], o[7], hi, true);
    return (u32x2){(unsigned)lo, (unsigned)hi}; }
__device__ __forceinline__ void unpack8_fp8(const u32x2 w, float (&o)[8]) {
    const f32x2 a = __builtin_amdgcn_cvt_pk_f32_fp8((int)w.x, false), b = __builtin_amdgcn_cvt_pk_f32_fp8((int)w.x, true);
    const f32x2 c = __builtin_amdgcn_cvt_pk_f32_fp8((int)w.y, false), d = __builtin_amdgcn_cvt_pk_f32_fp8((int)w.y, true);
    o[0] = a.x; o[1] = a.y; o[2] = b.x; o[3] = b.y; o[4] = c.x; o[5] = c.y; o[6] = d.x; o[7] = d.y; }
#define LDS_WAIT() asm volatile("s_waitcnt lgkmcnt(0)" ::: "memory")

namespace pg8 {
#define PG8_LAS __attribute__((address_space(3)))
constexpr int BM = 256, BK = 64, HALF = 128, HTB = HALF * BK * 2, STAGE_BYTES = 8 * HTB, NXCD = 8, WGM = 8;
__host__ __device__ __forceinline__ int lds_byte(int r, int c) { const int st = (r >> 4) * 2 + (c >> 5), rr = r & 15, cc = c & 31, ob = rr * 64 + cc * 2; return st * 1024 + (ob ^ (((ob >> 9) & 1) << 5)); }
__host__ __device__ __forceinline__ void stage_rc(int b, int& R, int& C) { const int st = b / 1024, sb = b % 1024, swz = sb ^ (((sb >> 9) & 1) << 5); R = (st >> 1) * 16 + swz / 64; C = (st & 1) * 32 + (swz % 64) / 2; }
__host__ __device__ __forceinline__ int perm32(int rho) { const int n = rho >> 4, i = rho & 15; return 8 * (i >> 2) + 4 * n + (i & 3); }

struct Unit { int pm, pn, e; };
struct Gemm { const bf16_t* A; const bf16_t* Bt; int M, N, K; size_t bgstride; };

struct StaticOrder {
    int nM, nN, nwg, G, c;
    __device__ void init(int nM_, int N, int G_, int c_) { nM = nM_; nN = N / BM; nwg = nM * nN; G = G_; c = c_; }
    __device__ bool next(int i, Unit& u) const {
        const long L = (long)i * G + c; if (L >= nwg) return false;
        int wgid = (int)L; { const int q = nwg / NXCD, r = nwg % NXCD, xcd = wgid % NXCD, off = wgid / NXCD; wgid = (xcd < r ? xcd * (q + 1) : r * (q + 1) + (xcd - r) * q) + off; }
        const int nig = WGM * nN, gid = wgid / nig, fm = gid * WGM, gsz = (nM - fm) < WGM ? (nM - fm) : WGM;
        u.pm = fm + ((wgid % nig) % gsz); u.pn = (wgid % nig) / gsz; u.e = 0; return true;
    }
};
struct GroupedOrder : StaticOrder {
    const PG8_LAS unsigned char* blk_e;
    __device__ bool next(int i, Unit& u) const { if (!StaticOrder::next(i, u)) return false; u.e = (int)blk_e[u.pm]; return true; }
};

__device__ __forceinline__ unsigned cvt_pk_bf16(float lo, float hi) { unsigned r; asm volatile("v_cvt_pk_bf16_f32 %0, %1, %2" : "=v"(r) : "v"(lo), "v"(hi)); return r; }

struct EpiProj {
    static constexpr bool PERM = true, WIDE = false;
    bf16_t* O;
    __device__ __forceinline__ void operator()(const f32x4 (&acc)[2][2][4][2], const Unit& u, int wr, int wc, int fr, int fq, int) const {
        const int row0 = u.pm * BM + wr * 64 + fr, c0 = wc * 32 + 8 * fq;
        if (u.pn < 4) {
#pragma unroll
            for (int ai = 0; ai < 2; ++ai)
#pragma unroll
                for (int m = 0; m < 4; ++m) { const f32x4 v0 = acc[ai][0][m][0] * acc[ai][1][m][0], v1 = acc[ai][0][m][1] * acc[ai][1][m][1];
                    u32x4 w; w.x = cvt_pk_bf16(v0[0], v0[1]); w.y = cvt_pk_bf16(v0[2], v0[3]); w.z = cvt_pk_bf16(v1[0], v1[1]); w.w = cvt_pk_bf16(v1[2], v1[3]);
                    *(u32x4*)(O + (size_t)(row0 + ai * HALF + m * 16) * NPO + 128 * u.pn + c0) = w; }
        } else {
            const int col0 = 512 + (u.pn - 4) * BM + c0;
#pragma unroll
            for (int ai = 0; ai < 2; ++ai)
#pragma unroll
                for (int m = 0; m < 4; ++m) { bf16_t* rowp = O + (size_t)(row0 + ai * HALF + m * 16) * NPO + col0;
#pragma unroll
                    for (int bj = 0; bj < 2; ++bj) { const f32x4 v0 = acc[ai][bj][m][0], v1 = acc[ai][bj][m][1];
                        u32x4 w; w.x = cvt_pk_bf16(v0[0], v0[1]); w.y = cvt_pk_bf16(v0[2], v0[3]); w.z = cvt_pk_bf16(v1[0], v1[1]); w.w = cvt_pk_bf16(v1[2], v1[3]);
                        *(u32x4*)(rowp + bj * HALF) = w; } }
        }
    }
};
struct EpiStoreBf16 {
    static constexpr bool PERM = true, WIDE = false;
    bf16_t* O; int ldc;
    __device__ __forceinline__ void operator()(const f32x4 (&acc)[2][2][4][2], const Unit& u, int wr, int wc, int fr, int fq, int) const {
        const int row0 = u.pm * BM + wr * 64 + fr, col0 = u.pn * BM + wc * 32 + 8 * fq;
#pragma unroll
        for (int ai = 0; ai < 2; ++ai)
#pragma unroll
            for (int m = 0; m < 4; ++m) { bf16_t* rowp = O + (size_t)(row0 + ai * HALF + m * 16) * ldc + col0;
#pragma unroll
                for (int bj = 0; bj < 2; ++bj) { const f32x4 v0 = acc[ai][bj][m][0], v1 = acc[ai][bj][m][1];
                    u32x4 w; w.x = cvt_pk_bf16(v0[0], v0[1]); w.y = cvt_pk_bf16(v0[2], v0[3]); w.z = cvt_pk_bf16(v1[0], v1[1]); w.w = cvt_pk_bf16(v1[2], v1[3]);
                    *(u32x4*)(rowp + bj * HALF) = w; } }
    }
};
template <bool IN_F32> struct EpiResidual {
    static constexpr bool PERM = true, WIDE = false;
    const void* xin; bf16_t* xout; const float* gvec; float wsc;
    __device__ __forceinline__ void operator()(const f32x4 (&acc)[2][2][4][2], const Unit& u, int wr, int wc, int fr, int fq, int) const {
        const int row0 = u.pm * BM + wr * 64 + fr, col0 = u.pn * BM + wc * 32 + 8 * fq;
        const float* gb = gvec + (size_t)((u.pm * BM) / SEQ) * (6 * D);
        f32x4 gv[2][2];
#pragma unroll
        for (int bj = 0; bj < 2; ++bj)
#pragma unroll
            for (int n = 0; n < 2; ++n) gv[bj][n] = *(const f32x4*)(gb + col0 + bj * HALF + 4 * n) * wsc;
#pragma unroll
        for (int ai = 0; ai < 2; ++ai)
#pragma unroll
            for (int m = 0; m < 4; ++m) { const size_t off = (size_t)(row0 + ai * HALF + m * 16) * D + col0;
                f32x4 x0[2], x1[2];
#pragma unroll
                for (int bj = 0; bj < 2; ++bj) {
                    if constexpr (IN_F32) { x0[bj] = *(const f32x4*)((const float*)xin + off + bj * HALF); x1[bj] = *(const f32x4*)((const float*)xin + off + bj * HALF + 4); }
                    else { const u32x4 w = *(const u32x4*)((const bf16_t*)xin + off + bj * HALF);
                        x0[bj] = (f32x4){__uint_as_float(w.x << 16), __uint_as_float(w.x & 0xffff0000u), __uint_as_float(w.y << 16), __uint_as_float(w.y & 0xffff0000u)};
                        x1[bj] = (f32x4){__uint_as_float(w.z << 16), __uint_as_float(w.z & 0xffff0000u), __uint_as_float(w.w << 16), __uint_as_float(w.w & 0xffff0000u)}; } }
#pragma unroll
                for (int bj = 0; bj < 2; ++bj) { const f32x4 v0 = x0[bj] + gv[bj][0] * acc[ai][bj][m][0], v1 = x1[bj] + gv[bj][1] * acc[ai][bj][m][1];
                    u32x4 w; w.x = cvt_pk_bf16(v0[0], v0[1]); w.y = cvt_pk_bf16(v0[2], v0[3]); w.z = cvt_pk_bf16(v1[0], v1[1]); w.w = cvt_pk_bf16(v1[2], v1[3]);
                    *(u32x4*)(xout + off + bj * HALF) = w; } }
    }
};
struct EpiGateUp {
    static constexpr bool PERM = true, WIDE = false;
    unsigned char* ACT; const PG8_LAS unsigned char* lds0; float wsc;
    __device__ __forceinline__ void operator()(const f32x4 (&acc)[2][2][4][2], const Unit& u, int wr, int wc, int fr, int fq, int ui) const {
        const int row0 = u.pm * BM + wr * 64 + fr, c0 = wc * 32 + 8 * fq, hc0 = u.pn * HALF + c0;
        f32x4 ba[2], bb[2];
        { const PG8_LAS unsigned char* bt = lds0 + (ui < 16 ? BIAS_OFF + ui * 512 : IDX_OFF + 17 * 512 + (ui - 16) * 512) + 2 * c0;
          const u32x4 wa = *(const PG8_LAS u32x4*)bt, wb = *(const PG8_LAS u32x4*)(bt + 256);
          ba[0] = (f32x4){__uint_as_float(wa.x << 16), __uint_as_float(wa.x & 0xffff0000u), __uint_as_float(wa.y << 16), __uint_as_float(wa.y & 0xffff0000u)};
          ba[1] = (f32x4){__uint_as_float(wa.z << 16), __uint_as_float(wa.z & 0xffff0000u), __uint_as_float(wa.w << 16), __uint_as_float(wa.w & 0xffff0000u)};
          bb[0] = (f32x4){__uint_as_float(wb.x << 16), __uint_as_float(wb.x & 0xffff0000u), __uint_as_float(wb.y << 16), __uint_as_float(wb.y & 0xffff0000u)};
          bb[1] = (f32x4){__uint_as_float(wb.z << 16), __uint_as_float(wb.z & 0xffff0000u), __uint_as_float(wb.w << 16), __uint_as_float(wb.w & 0xffff0000u)}; }
#pragma unroll
        for (int ai = 0; ai < 2; ++ai)
#pragma unroll
            for (int m = 0; m < 4; ++m) { float o[8];
#pragma unroll
                for (int n = 0; n < 2; ++n)
#pragma unroll
                    for (int h = 0; h < 2; ++h) {
                        f32x2 a = (f32x2){acc[ai][0][m][n][2 * h], acc[ai][0][m][n][2 * h + 1]} * wsc + (f32x2){ba[n][2 * h], ba[n][2 * h + 1]};
                        f32x2 b = (f32x2){acc[ai][1][m][n][2 * h], acc[ai][1][m][n][2 * h + 1]} * wsc + (f32x2){bb[n][2 * h], bb[n][2 * h + 1]};
                        a.x = fminf(a.x, 7.0f); a.y = fminf(a.y, 7.0f);
                        b.x = __builtin_amdgcn_fmed3f(b.x, -7.0f, 7.0f); b.y = __builtin_amdgcn_fmed3f(b.y, -7.0f, 7.0f);
                        const f32x2 t = a * -2.45546696f;
                        const f32x2 d = (f32x2){__builtin_amdgcn_exp2f(t.x), __builtin_amdgcn_exp2f(t.y)} + 1.0f;
                        const f32x2 r = (f32x2){__builtin_amdgcn_rcpf(d.x), __builtin_amdgcn_rcpf(d.y)};
                        const f32x2 res = (a * r) * (b + 1.0f);
                        o[4 * n + 2 * h] = res.x; o[4 * n + 2 * h + 1] = res.y; }
                *(u32x2*)(ACT + (size_t)(row0 + ai * HALF + m * 16) * D + hc0) = pack8_fp8(o); }
    }
};
struct EpiDown {
    static constexpr bool PERM = true, WIDE = true;
    unsigned char* SLOT; const PG8_LAS unsigned char* lds0;
    const PG8_LAS int* slot_tab;
    float wsc;
    __device__ __forceinline__ void operator()(const f32x4 (&acc)[2][2][4][2], const Unit& u, int wr, int wc, int fr, int fq, int ui) const {
        const int c0 = wc * 64 + 16 * fq, col0 = u.pn * BM + c0;
        const PG8_LAS int* st = slot_tab + ui * BM + wr * 64 + fr;
        f32x4 bv[2][2];
#pragma unroll
        for (int bj = 0; bj < 2; ++bj) { const u32x4 w = *(const PG8_LAS u32x4*)(lds0 + BIAS_OFF + ui * 512 + 2 * (c0 + 8 * bj));
            bv[bj][0] = (f32x4){__uint_as_float(w.x << 16), __uint_as_float(w.x & 0xffff0000u), __uint_as_float(w.y << 16), __uint_as_float(w.y & 0xffff0000u)};
            bv[bj][1] = (f32x4){__uint_as_float(w.z << 16), __uint_as_float(w.z & 0xffff0000u), __uint_as_float(w.w << 16), __uint_as_float(w.w & 0xffff0000u)}; }
#pragma unroll
        for (int ai = 0; ai < 2; ++ai)
#pragma unroll
            for (int m = 0; m < 4; ++m) { const int slot = st[ai * HALF + m * 16];
                if (slot >= 0) { u32x4 w4;
#pragma unroll
                    for (int bj = 0; bj < 2; ++bj) { const f32x4 v0 = acc[ai][bj][m][0] * wsc + bv[bj][0], v1 = acc[ai][bj][m][1] * wsc + bv[bj][1];
                        const float o[8] = {v0[0], v0[1], v0[2], v0[3], v1[0], v1[1], v1[2], v1[3]}; const u32x2 pk = pack8_fp8(o);
                        if (bj == 0) { w4.x = pk.x; w4.y = pk.y; } else { w4.z = pk.x; w4.w = pk.y; } }
                    *(u32x4*)(SLOT + (size_t)slot * D + col0) = w4; } }
    }
};

template <class Epi, class Sched, bool GATHER = false, bool FP8 = false, bool ALIGN_EPI = true>
__device__ __forceinline__ void gemm_phase(PG8_LAS unsigned char* lds, const Gemm g, const Sched& S, const Epi& E, const int tid, const PG8_LAS unsigned short* idx = nullptr) {
    const int wid = __builtin_amdgcn_readfirstlane(tid >> 6), lane = tid & 63, wr = wid >> 2, wc = wid & 3, fr = lane & 15, fq = lane >> 4;
    const int K = g.K, nt = K / BK;
    unsigned voffB[2]; int Ra[2], Ca[2];
#pragma unroll
    for (int i = 0; i < 2; ++i) { int R, C; stage_rc(tid * 16 + i * 8192, R, C);
        const int Rb = Epi::WIDE ? (64 * (R >> 5) + 16 * ((R & 15) >> 2) + 4 * ((R >> 4) & 1) + (R & 3)) : (Epi::PERM ? ((R & ~31) + perm32(R & 31)) : R);
        Ra[i] = R; Ca[i] = C; voffB[i] = (unsigned)(Rb * K + C) * 2u; }
    const size_t bhs = Epi::WIDE ? (size_t)8 * K * 2 : (size_t)HALF * K * 2;
    const size_t kstep = (size_t)(BK * 2);
    const size_t hstep = (size_t)HALF * K * 2;
    const size_t tstep = 2 * hstep;
    const unsigned ldsw = (unsigned)wid * 1024u;
    const int aoff = lds_byte(wr * 64 + fr, fq * 8), boff = lds_byte(wc * 32 + fr, fq * 8);
#define PG8_SA(b, h) (((b) * 2 + (h)) * HTB)
#define PG8_SB(b, h) ((4 + (b) * 2 + (h)) * HTB)
#define PG8_STAGE(bufoff, gbase, voff) do { _Pragma("unroll") for (int _i = 0; _i < 2; ++_i) \
        __builtin_amdgcn_global_load_lds((const unsigned*)((const char*)(gbase) + (voff)[_i]), (PG8_LAS unsigned*)(lds + (bufoff) + ldsw + _i * 8192), 16, 0, 0); } while (0)
#define PG8_LDA(dst, b, h) do { _Pragma("unroll") for (int m = 0; m < 4; ++m) _Pragma("unroll") for (int k = 0; k < 2; ++k) dst[m][k] = *(const PG8_LAS bf16x8*)(lds + PG8_SA(b, h) + aoff + m * 2048 + k * 1024); } while (0)
#define PG8_LDB(dst, b, h) do { _Pragma("unroll") for (int n = 0; n < 2; ++n) _Pragma("unroll") for (int k = 0; k < 2; ++k) dst[n][k] = *(const PG8_LAS bf16x8*)(lds + PG8_SB(b, h) + boff + n * 2048 + k * 1024); } while (0)
#define PG8_MMA(ai, bj, At, Bt) do { __builtin_amdgcn_s_setprio(1); _Pragma("unroll") for (int m = 0; m < 4; ++m) _Pragma("unroll") for (int n = 0; n < 2; ++n) { \
        if constexpr (FP8) { typedef int v4i_ __attribute__((ext_vector_type(4))); typedef int v8i_ __attribute__((ext_vector_type(8))); \
            const v8i_ wa = __builtin_shufflevector(__builtin_bit_cast(v4i_, Bt[n][0]), __builtin_bit_cast(v4i_, Bt[n][1]), 0, 1, 2, 3, 4, 5, 6, 7); \
            const v8i_ xa = __builtin_shufflevector(__builtin_bit_cast(v4i_, At[m][0]), __builtin_bit_cast(v4i_, At[m][1]), 0, 1, 2, 3, 4, 5, 6, 7); \
            acc[ai][bj][m][n] = __builtin_amdgcn_mfma_scale_f32_16x16x128_f8f6f4(wa, xa, acc[ai][bj][m][n], 0, 0, 0, 0x7f7f7f7f, 0, 0x7f7f7f7f); } \
        else { _Pragma("unroll") for (int k = 0; k < 2; ++k) acc[ai][bj][m][n] = __builtin_amdgcn_mfma_f32_16x16x32_bf16(Bt[n][k], At[m][k], acc[ai][bj][m][n], 0, 0, 0); } } \
        __builtin_amdgcn_s_setprio(0); } while (0)
#define PG8_WAIT_V(n) asm volatile("s_waitcnt vmcnt(" #n ")" ::: "memory")
#define PG8_WAIT_L(n) asm volatile("s_waitcnt lgkmcnt(" #n ")" ::: "memory")
#define PG8_BAR __builtin_amdgcn_s_barrier()
#define PG8_SCHED __builtin_amdgcn_sched_barrier(0)
#define PG8_AOFFS(dst, ui_, pm_) do { _Pragma("unroll") for (int _h = 0; _h < 2; ++_h) _Pragma("unroll") for (int _i = 0; _i < 2; ++_i) { \
        if constexpr (GATHER) dst[_h][_i] = (idx ? (unsigned)idx[(ui_) * BM + _h * HALF + Ra[_i]] : (unsigned)((pm_) * BM + _h * HALF + Ra[_i])) * (unsigned)(K * 2) + (unsigned)(Ca[_i] * 2); \
        else dst[_h][_i] = (unsigned)((_h * HALF + Ra[_i]) * K + Ca[_i]) * 2u; } } while (0)
    Unit cur, nxt; int ui = 0;
    if (!S.next(0, cur)) return;
    f32x4 acc[2][2][4][2];
#pragma unroll
    for (int a = 0; a < 2; ++a)
#pragma unroll
        for (int b = 0; b < 2; ++b)
#pragma unroll
            for (int m = 0; m < 4; ++m)
#pragma unroll
                for (int n = 0; n < 2; ++n) acc[a][b][m][n] = (f32x4){0.f, 0.f, 0.f, 0.f};
    bf16x8 At[4][2], B0[2][2], B1[2][2];
    unsigned offA[2][2];
    PG8_AOFFS(offA, 0, cur.pm);
    const char* cA = GATHER ? (const char*)g.A : (const char*)g.A + (size_t)cur.pm * tstep;
    const char* cB = (const char*)g.Bt + (size_t)cur.e * g.bgstride + (size_t)cur.pn * tstep;
    PG8_STAGE(PG8_SB(0, 0), cB, voffB); PG8_STAGE(PG8_SB(0, 1), cB + bhs, voffB); PG8_STAGE(PG8_SA(0, 0), cA, offA[0]); PG8_STAGE(PG8_SA(0, 1), cA, offA[1]);
    if (wr == 1) PG8_BAR;
    PG8_WAIT_V(2); PG8_BAR;
    PG8_STAGE(PG8_SB(1, 0), cB + kstep, voffB); PG8_STAGE(PG8_SA(1, 0), cA + kstep, offA[0]); PG8_STAGE(PG8_SB(1, 1), cB + bhs + kstep, voffB);
    PG8_WAIT_V(6); PG8_BAR;
    for (;;) {
        const bool has_next = S.next(ui + 1, nxt);
        const char* nA = GATHER ? (const char*)g.A : (has_next ? (const char*)g.A + (size_t)nxt.pm * tstep : cA);
        const char* nB = has_next ? (const char*)g.Bt + (size_t)nxt.e * g.bgstride + (size_t)nxt.pn * tstep : cB;
        for (int t = 0; t < nt; t += 2) {
            const bool last = (t == nt - 2);
            const char* a1 = cA + (size_t)(t + 1) * kstep;
            const char* a2 = last ? nA : cA + (size_t)(t + 2) * kstep; const char* b2 = last ? nB : cB + (size_t)(t + 2) * kstep;
            const char* a3 = a2 + kstep; const char* b3 = b2 + kstep;
            PG8_LDB(B0, 0, 0); PG8_LDB(B1, 0, 1); PG8_SCHED; PG8_LDA(At, 0, 0); PG8_STAGE(PG8_SA(1, 1), a1, offA[1]);
            if constexpr (GATHER) { if (last && has_next) PG8_AOFFS(offA, ui + 1, nxt.pm); }
            PG8_WAIT_V(8); PG8_WAIT_L(0); PG8_BAR; PG8_MMA(0, 0, At, B0); PG8_MMA(0, 1, At, B1); PG8_BAR; PG8_SCHED;
            PG8_LDA(At, 0, 1); PG8_STAGE(PG8_SB(0, 0), b2, voffB); PG8_STAGE(PG8_SB(0, 1), b2 + bhs, voffB); PG8_STAGE(PG8_SA(0, 0), a2, offA[0]);
            PG8_WAIT_V(8); PG8_WAIT_L(0); PG8_BAR; PG8_MMA(1, 0, At, B0); PG8_MMA(1, 1, At, B1); PG8_BAR; PG8_SCHED;
            PG8_LDB(B0, 1, 0); PG8_LDB(B1, 1, 1); PG8_SCHED; PG8_LDA(At, 1, 0); PG8_STAGE(PG8_SA(0, 1), a2, offA[1]);
            PG8_WAIT_V(8); PG8_WAIT_L(0); PG8_BAR; PG8_MMA(0, 0, At, B0); PG8_MMA(0, 1, At, B1); PG8_BAR; PG8_SCHED;
            PG8_LDA(At, 1, 1); PG8_STAGE(PG8_SB(1, 0), b3, voffB); PG8_STAGE(PG8_SB(1, 1), b3 + bhs, voffB); PG8_STAGE(PG8_SA(1, 0), a3, offA[0]);
            PG8_WAIT_V(8); PG8_WAIT_L(0); PG8_BAR; PG8_MMA(1, 0, At, B0); PG8_MMA(1, 1, At, B1); PG8_BAR; PG8_SCHED;
        }
        if constexpr (ALIGN_EPI) { if (wr == 0) PG8_BAR; }
        E(acc, cur, wr, wc, fr, fq, ui);
        if (!has_next) break;
#pragma unroll
        for (int a = 0; a < 2; ++a)
#pragma unroll
            for (int b = 0; b < 2; ++b)
#pragma unroll
                for (int m = 0; m < 4; ++m)
#pragma unroll
                    for (int n = 0; n < 2; ++n) acc[a][b][m][n] = (f32x4){0.f, 0.f, 0.f, 0.f};
        cur = nxt; cA = nA; cB = nB; ++ui;
        if constexpr (ALIGN_EPI) { if (wr == 1) PG8_BAR; }
    }
    PG8_WAIT_V(0);
    if constexpr (!ALIGN_EPI) { if (wr == 0) PG8_BAR; }
    PG8_BAR;
#undef PG8_SA
#undef PG8_SB
#undef PG8_STAGE
#undef PG8_LDA
#undef PG8_LDB
#undef PG8_MMA
#undef PG8_WAIT_V
#undef PG8_WAIT_L
#undef PG8_BAR
#undef PG8_SCHED
#undef PG8_AOFFS
}
}

#define XB_TMO      128
#define XB_XCNT(j)  (256  + 64 * (j))
#define XB_XSUB(j)  (1280 + 64 * (j))
#define XB_XGEN(j)  (2304 + 64 * (j))
#define XB_TOP      3328
#define XB_TOPGEN   3392
#define XCD_BAR_WORDS 3456
#define XB_SPIN_CAP (1u << 21)

__device__ __forceinline__ unsigned xb_ld(unsigned* p)              { return __hip_atomic_load(p, __ATOMIC_RELAXED, __HIP_MEMORY_SCOPE_AGENT); }
__device__ __forceinline__ unsigned xb_add(unsigned* p, unsigned v) { return __hip_atomic_fetch_add(p, v, __ATOMIC_RELAXED, __HIP_MEMORY_SCOPE_AGENT); }
__device__ __forceinline__ unsigned xb_xcc_id() { return (unsigned)__builtin_amdgcn_s_getreg((3 << 11) | 20) & 0xFu; }
#define XB_SPIN(cond, bar) do { unsigned _sp = 0; while (cond) { __builtin_amdgcn_s_sleep(1); \
    if ((++_sp & 255u) == 0u) { if (xb_ld(&(bar)[XB_TMO])) break; if (_sp > XB_SPIN_CAP) { atomicAdd(&(bar)[XB_TMO], 1u); break; } } } } while (0)

struct XcdBarrier { unsigned* bar; unsigned x; volatile LAS unsigned* st; };

__device__ __forceinline__ XcdBarrier xcd_barrier_post(unsigned* bar, volatile LAS unsigned* st) {
    XcdBarrier b; b.bar = bar; b.x = xb_xcc_id(); b.st = st;
    if (threadIdx.x == 0) (void)xb_add(&bar[XB_XCNT(b.x)], 1u);
    return b;
}
__device__ __forceinline__ void xcd_barrier_complete(unsigned* bar, unsigned x, unsigned& nloc, unsigned& nx) {
    const unsigned G = gridDim.x * gridDim.y * gridDim.z;
    unsigned sum, cnt, mine, sp = 0u;
    for (;;) {
        sum = 0u; cnt = 0u; mine = 0u;
#pragma unroll
        for (unsigned j = 0; j < 16; ++j) { const unsigned c = xb_ld(&bar[XB_XCNT(j)]); sum += c; cnt += (c > 0u) ? 1u : 0u; mine = (j == x) ? c : mine; }
        if (sum == G) break;
        __builtin_amdgcn_s_sleep(1);
        if ((++sp & 255u) == 0u) { if (xb_ld(&bar[XB_TMO])) break; if (sp > XB_SPIN_CAP) { atomicAdd(&bar[XB_TMO], 1u); break; } }
    }
    nloc = mine > 0u ? mine : 1u; nx = cnt > 0u ? cnt : 1u;
}
__device__ __forceinline__ void xcd_barrier(const XcdBarrier& b) {
    asm volatile("s_waitcnt vmcnt(0)" ::: "memory");
    __syncthreads();
    if (threadIdx.x == 0) {
        unsigned* bar = b.bar;
        __builtin_amdgcn_s_waitcnt(0);
        unsigned nloc = b.st[0], nx = b.st[1];
        if (nloc == 0u) { xcd_barrier_complete(bar, b.x, nloc, nx); b.st[0] = nloc; b.st[1] = nx; }
        const unsigned old = xb_add(&bar[XB_XSUB(b.x)], 1u);
        const unsigned gen = old / nloc;
        if (old + 1u == (gen + 1u) * nloc) {
            __builtin_amdgcn_fence(__ATOMIC_RELEASE, "agent");
            asm volatile("s_waitcnt vmcnt(0)" ::: "memory");
            const unsigned og = xb_add(&bar[XB_TOP], 1u);
            const unsigned tg = og / nx;
            if (og + 1u == (tg + 1u) * nx) xb_add(&bar[XB_TOPGEN], 1u);
            else XB_SPIN(xb_ld(&bar[XB_TOPGEN]) == tg, bar);
            __builtin_amdgcn_fence(__ATOMIC_ACQUIRE, "agent");
            xb_add(&bar[XB_XGEN(b.x)], 1u);
            asm volatile("s_waitcnt vmcnt(0)" ::: "memory");
        } else {
            XB_SPIN(xb_ld(&bar[XB_XGEN(b.x)]) == gen, bar);
            __builtin_amdgcn_fence(__ATOMIC_ACQUIRE, "agent");
            asm volatile("s_waitcnt vmcnt(0)" ::: "memory");
        }
    }
    __syncthreads();
}

struct Params {
    const float* x; const float* c; const float* w_ada; const float* b_ada; const float* norm1_g; const float* norm2_g; const float* w_in; const float* conv_w;
    const float* conv_norm_g; const float* lower_bounds; const float* hgrn_norm_g; const float* w_out; const float* w_router; const float* b_router;
    const float* w_gu; const float* b_gu; const float* w_down; const float* b_down; const float* final_g;
    float* out; unsigned char* ws;
    int ph_lo, ph_hi;
};

struct Ctx {
    LAS unsigned char* lds; int tid, lane, wave, G, gw, NGW, bid;
};
__device__ __forceinline__ Ctx make_ctx(LAS unsigned char* lds) {
    Ctx cx; int tid = threadIdx.x; asm volatile("" : "+v"(tid)); int bid = blockIdx.x; asm volatile("" : "+s"(bid)); int G = gridDim.x; asm volatile("" : "+s"(G));
    cx.lds = lds; cx.tid = tid; cx.lane = tid & 63; cx.wave = __builtin_amdgcn_readfirstlane(tid >> 6); cx.G = G; cx.gw = bid * 8 + cx.wave; cx.NGW = G * 8; cx.bid = bid;
    return cx;
}
__device__ __forceinline__ unsigned char* launder(unsigned char* q) { GAS unsigned char* g = (GAS unsigned char*)q; asm volatile("" : "+s"(g)); return (unsigned char*)g; }

__device__ __forceinline__ void transpose_item(const float* W, int N, bf16_t* WT, int k0, int n0, int wt_row0, LAS float* scr, int lane) {
    { float v[64];
#pragma unroll
      for (int i = 0; i < 64; ++i) v[i] = W[(size_t)(k0 + i) * N + n0 + lane];
#pragma unroll
      for (int i = 0; i < 64; ++i) scr[i * 65 + lane] = v[i]; }
    LDS_WAIT();
    const int c = lane & 7;
#pragma unroll
    for (int j = 0; j < 8; ++j) { const int n = (lane >> 3) + 8 * j; const LAS float* s = scr + (8 * c) * 65 + n;
        u32x4 o; o.x = pk2(s[0], s[65]); o.y = pk2(s[130], s[195]); o.z = pk2(s[260], s[325]); o.w = pk2(s[390], s[455]);
        *(u32x4*)(WT + (size_t)(wt_row0 + n) * D + k0 + 8 * c) = o; }
    LDS_WAIT();
}
__device__ __forceinline__ void transpose_item_fp8(const float* W, int N, unsigned char* WT, int k0, int n0, int wt_row0, float scale, LAS float* scr, int lane) {
    const int kq = lane >> 4, nq = lane & 15;
    f32x4 ld[16];
#pragma unroll
    for (int i = 0; i < 16; ++i) ld[i] = __builtin_nontemporal_load((const f32x4*)(W + (size_t)(k0 + 4 * i + kq) * N + n0 + 4 * nq));
#pragma unroll
    for (int i = 0; i < 16; ++i) *(LAS f32x4*)(scr + (4 * i + kq) * 68 + 4 * nq) = ld[i];
    LDS_WAIT();
    float v[64];
#pragma unroll
    for (int i = 0; i < 64; ++i) v[i] = scr[i * 68 + lane];
    LDS_WAIT();
    LAS unsigned char* sb = (LAS unsigned char*)scr;
#pragma unroll
    for (int q = 0; q < 4; ++q) { float o0[8], o1[8];
#pragma unroll
        for (int i = 0; i < 8; ++i) { o0[i] = v[16 * q + i] * scale; o1[i] = v[16 * q + 8 + i] * scale; }
        const u32x2 a = pack8_fp8(o0), c = pack8_fp8(o1);
        *(LAS u32x4*)(sb + lane * 80 + 16 * q) = (u32x4){a.x, a.y, c.x, c.y}; }
    LDS_WAIT();
#pragma unroll
    for (int i = 0; i < 4; ++i) { const int row = (lane >> 2) + 16 * i, pc = lane & 3;
        const u32x4 w = *(const LAS u32x4*)(sb + row * 80 + 16 * pc);
        *(u32x4*)(WT + (size_t)(wt_row0 + row) * D + k0 + 16 * pc) = w; }
    LDS_WAIT();
}
__device__ __forceinline__ void convert_item(const Params& p, unsigned char* ws, int l, int which, int it, LAS float* scr, int lane) {
    constexpr int I_GU = 16 * 32, I_DN = 16 * 16;
    if (which == 0) { const int mtx = l * NE + it / I_GU, q = it % I_GU, nb = q % 32, kb = q / 32; const int n0 = nb * 64;
        const int row0 = (n0 < 1024) ? (256 * (n0 >> 7) + (n0 & 127)) : (256 * ((n0 - 1024) >> 7) + 128 + ((n0 - 1024) & 127));
        transpose_item_fp8(p.w_gu + (size_t)mtx * D * 2048, 2048, (unsigned char*)(ws + WS_WGU) + (size_t)mtx * 2048 * D, kb * 64, n0, row0, WGU_SCALE, scr, lane);
    } else { const int mtx = l * NE + it / I_DN, q = it % I_DN, nb = q % 16, kb = q / 16;
        transpose_item_fp8(p.w_down + (size_t)mtx * D * D, D, (unsigned char*)(ws + WS_WDN) + (size_t)mtx * D * D, kb * 64, nb * 64, nb * 64, WGU_SCALE, scr, lane); }
}
constexpr int CONV_DELTA = 4;
constexpr int CONV_TOT_GU = NE * 16 * 32, CONV_TOT_DN = NE * 16 * 16;
constexpr int CONV_STAT_GU = CONV_TOT_GU * 3 / 4, CONV_STAT_DN = CONV_TOT_DN * 3 / 4;
__device__ __forceinline__ void convert_expert_weights(const Params& p, const Ctx& cx, unsigned char* ws, int l, int which, int r_hi = 0) {
    LAS float* scr = (LAS float*)(cx.lds + cx.wave * 17408);
    if (which == 0) {
        for (int it = cx.gw; it < CONV_STAT_GU; it += cx.NGW) convert_item(p, ws, l, 0, it, scr, cx.lane);
    } else {
        const int wlo = cx.G - r_hi; int rhi = (CONV_STAT_DN - CONV_DELTA * wlo * 8 + cx.NGW / 2) / cx.NGW; rhi = rhi < 0 ? 0 : rhi;
        for (int j = 0;; ++j) { int it;
            if (j < rhi) it = j * cx.NGW + cx.gw; else { if (cx.bid < r_hi) break; it = rhi * cx.NGW + (j - rhi) * wlo * 8 + (cx.bid - r_hi) * 8 + cx.wave; }
            if (it >= CONV_STAT_DN) break;
            convert_item(p, ws, l, 1, it, scr, cx.lane); }
    }
    __syncthreads();
}
__device__ __forceinline__ void convert_tail(const Params& p, const Ctx& cx, unsigned char* ws, int l, int which) {
    LAS float* scr = (LAS float*)(cx.lds + cx.wave * 17408);
    volatile LAS int* tick = (volatile LAS int*)(cx.lds + MISC_OFF + MS_BAR + 32);
    unsigned* q = (unsigned*)(ws + WS_CTL) + CW_QUEUE + 64 * (2 * l + which);
    const int first = which == 0 ? CONV_STAT_GU : CONV_STAT_DN, total = which == 0 ? CONV_TOT_GU : CONV_TOT_DN;
    if (cx.tid == 0) tick[0] = (int)__hip_atomic_fetch_add(q, 8u, __ATOMIC_RELAXED, __HIP_MEMORY_SCOPE_AGENT);
    __syncthreads();
    int t = tick[0], par = 0;
    while (first + t < total) {
        int nt = 0;
        if (cx.tid == 0) nt = (int)__hip_atomic_fetch_add(q, 8u, __ATOMIC_RELAXED, __HIP_MEMORY_SCOPE_AGENT);
        const int it = first + t + cx.wave;
        if (it < total) convert_item(p, ws, l, which, it, scr, cx.lane);
        par ^= 1;
        if (cx.tid == 0) tick[par] = nt;
        __syncthreads();
        t = tick[par];
    }
    __syncthreads();
}
__device__ __forceinline__ void phase_prologue(const Params& p, LAS unsigned char* ldsb) {
    const Ctx cx = make_ctx(ldsb);
    unsigned char* ws = launder(p.ws);
    LAS float* scr = (LAS float*)(cx.lds + cx.wave * 17408);
    constexpr int I_IN = 16 * (NPROJ / 64), I_OUT = 16 * 16;
    constexpr int T_IN = DEPTH * I_IN, T_OUT = DEPTH * I_OUT;
    for (int it = cx.gw; it < T_IN + T_OUT; it += cx.NGW) {
        int r = it;
        if (r < T_IN) { const int mtx = r / I_IN, q = r % I_IN, nb = q % (NPROJ / 64), kb = q / (NPROJ / 64);
            transpose_item(p.w_in + (size_t)mtx * D * NPROJ, NPROJ, (bf16_t*)(ws + WS_WIN) + (size_t)mtx * NPROJ * D, kb * 64, nb * 64, win_row(nb * 64), scr, cx.lane); continue; }
        r -= T_IN;
        { const int mtx = r / I_OUT, q = r % I_OUT, nb = q % 16, kb = q / 16;
            transpose_item_fp8(p.w_out + (size_t)mtx * D * D, D, (unsigned char*)(ws + WS_WOUT) + (size_t)mtx * D * D, kb * 64, nb * 64, nb * 64, WGU_SCALE, scr, cx.lane); }
    }
    __syncthreads();
    {
        LAS float* cact = (LAS float*)(cx.lds);
        LAS float* part = (LAS float*)(cx.lds + 8192);
        bool have = false;
        for (int item = cx.bid; item < DEPTH * 48; item += cx.G) {
            if (!have) { for (int i = cx.tid; i < 2 * D; i += 512) { const float v = p.c[i]; cact[i] = v / (1.0f + __expf(-v)); } have = true; __syncthreads(); }
            const int l = item / 48, col0 = (item % 48) * 128;
            const float* wp = p.w_ada + ((size_t)l * D + cx.wave * 128) * (6 * D) + col0 + 2 * cx.lane;
            float a00 = 0.f, a01 = 0.f, a10 = 0.f, a11 = 0.f;
#pragma unroll 8
            for (int kk = 0; kk < 128; ++kk) { const f32x2 wv = *(const f32x2*)(wp + (size_t)kk * (6 * D)); const float c0 = cact[cx.wave * 128 + kk], c1 = cact[D + cx.wave * 128 + kk];
                a00 += c0 * wv.x; a01 += c0 * wv.y; a10 += c1 * wv.x; a11 += c1 * wv.y; }
            part[(cx.wave * 2 + 0) * 128 + 2 * cx.lane] = a00; part[(cx.wave * 2 + 0) * 128 + 2 * cx.lane + 1] = a01;
            part[(cx.wave * 2 + 1) * 128 + 2 * cx.lane] = a10; part[(cx.wave * 2 + 1) * 128 + 2 * cx.lane + 1] = a11;
            __syncthreads();
            if (cx.tid < 256) { const int b = cx.tid >> 7, col = cx.tid & 127; float s = p.b_ada[(size_t)l * 6 * D + col0 + col];
#pragma unroll
                for (int w = 0; w < 8; ++w) s += part[(w * 2 + b) * 128 + col];
                ((float*)(ws + WS_ADA))[((size_t)l * 2 + b) * (6 * D) + col0 + col] = s; }
            __syncthreads();
        }
    }
    if (cx.bid == cx.G - 1) {
        const int ch = cx.tid;
        float v[DEPTH], m = -3.0e38f;
#pragma unroll
        for (int l = 0; l < DEPTH; ++l) { v[l] = p.lower_bounds[l * 512 + ch]; m = fmaxf(m, v[l]); }
        float s = 0.f;
#pragma unroll
        for (int l = 0; l < DEPTH; ++l) { v[l] = __expf(v[l] - m); s += v[l]; }
        float run = 0.f; float* LB = (float*)(ws + WS_LB);
        LB[ch] = 0.f;
#pragma unroll
        for (int l = 1; l < DEPTH; ++l) { run += v[l] / s; LB[l * 512 + ch] = run; }
    }
}

__device__ __forceinline__ void norm_mod_store(const f32x4 (&v)[4], const float* gnorm, const float* shift, const float* scale, bf16_t* orow, int lane) {
    float ss = 0.f;
#pragma unroll
    for (int j = 0; j < 4; ++j) ss += (v[j].x * v[j].x + v[j].y * v[j].y) + (v[j].z * v[j].z + v[j].w * v[j].w);
    const float rstd = frsq(wave_sum(ss) * (1.0f / D) + RMS_EPS);
#pragma unroll
    for (int j = 0; j < 4; ++j) { const int c = 4 * lane + 256 * j;
        const f32x4 g = *(const f32x4*)(gnorm + c), sh = *(const f32x4*)(shift + c), sc = *(const f32x4*)(scale + c);
        const f32x4 y = (v[j] * rstd) * g * (sc + 1.0f) + sh;
        u32x2 w; w.x = pk2(y.x, y.y); w.y = pk2(y.z, y.w);
        *(u32x2*)(orow + c) = w; }
}
__device__ __forceinline__ void norm_mod_store8(const float (&v)[2][8], const float* gnorm, const float* shift, const float* scale, bf16_t* orow, int lane) {
    float ss = 0.f;
#pragma unroll
    for (int j = 0; j < 2; ++j)
#pragma unroll
        for (int i = 0; i < 8; ++i) ss += v[j][i] * v[j][i];
    const float rstd = frsq(wave_sum(ss) * (1.0f / D) + RMS_EPS);
#pragma unroll
    for (int j = 0; j < 2; ++j) { const int c = 8 * lane + 512 * j; float o[8];
#pragma unroll
        for (int h = 0; h < 2; ++h) { const f32x4 g = *(const f32x4*)(gnorm + c + 4 * h), sh = *(const f32x4*)(shift + c + 4 * h), sc = *(const f32x4*)(scale + c + 4 * h);
#pragma unroll
            for (int i = 0; i < 4; ++i) o[4 * h + i] = (v[j][4 * h + i] * rstd) * g[i] * (sc[i] + 1.0f) + sh[i]; }
        *(u32x4*)(orow + c) = pack8(o); }
}
__device__ __forceinline__ void phase_norm1_first(const Params& p, LAS unsigned char* ldsb) {
    const Ctx cx = make_ctx(ldsb);
    unsigned char* ws = launder(p.ws);
    const float* ada = (const float*)(ws + WS_ADA);
    bf16_t* HN = (bf16_t*)(ws + WS_HN);
    for (int row = cx.gw; row < NTOK; row += cx.NGW) {
        const int b = row / SEQ; f32x4 v[4];
#pragma unroll
        for (int j = 0; j < 4; ++j) v[j] = *(const f32x4*)(p.x + (size_t)row * D + 4 * cx.lane + 256 * j);
        norm_mod_store(v, p.norm1_g, ada + (size_t)b * 6 * D + 0 * D, ada + (size_t)b * 6 * D + 1 * D, HN + (size_t)row * D, cx.lane);
    }
    if (cx.bid == cx.G - 1 && cx.tid < 64) ((u32x4*)(ws + WS_HN8 + (size_t)NTOK * D))[cx.tid] = (u32x4){0u, 0u, 0u, 0u};
    { u32x4* WLG = (u32x4*)(ws + WS_WL);
      for (int idx = cx.bid * 512 + cx.tid; idx < DEPTH * 2 * 4096; idx += cx.G * 512) { const int lb2 = idx >> 12, f = idx & 4095, l = lb2 >> 1, b = lb2 & 1;
          const int sk = f >> 7, nt = (f >> 6) & 1, ln = f & 63, gg = ln >> 4, c = ln & 15, k0 = 32 * sk + 8 * gg, e = 16 * nt + c;
          const float* sc = ada + ((size_t)l * 2 + b) * 6 * D + 4 * D; const float* gn = p.norm2_g + (size_t)l * D; const float* wr_l = p.w_router + (size_t)l * D * NE;
          float hi[8], lo[8];
#pragma unroll
          for (int i = 0; i < 8; ++i) { const float w = gn[k0 + i] * (1.0f + sc[k0 + i]) * wr_l[(size_t)(k0 + i) * NE + e]; const float h = __uint_as_float(f2bf(w) << 16); hi[i] = h; lo[i] = w - h; }
          u32x4* dst = WLG + (size_t)lb2 * 8192 + (size_t)((sk * 2 + nt) * 2) * 64 + ln;
          dst[0] = pack8(hi); dst[64] = pack8(lo); } }
    for (int item = cx.bid; item < DEPTH * 2; item += cx.G) {
        const int l = item >> 1, b = item & 1; LAS float* part = (LAS float*)cx.lds;
        const float* sh = ada + ((size_t)l * 2 + b) * 6 * D + 3 * D; const float* wr_l = p.w_router + (size_t)l * D * NE;
        const int e = cx.tid & 31, pt = cx.tid >> 5; float s = 0.f;
        for (int k = pt * 64; k < pt * 64 + 64; ++k) s += sh[k] * wr_l[(size_t)k * NE + e];
        __syncthreads(); part[pt * 32 + e] = s; __syncthreads();
        if (cx.tid < NE) { float t = p.b_router[(size_t)l * NE + cx.tid];
#pragma unroll
            for (int q = 0; q < 16; ++q) t += part[q * 32 + cx.tid];
            ((float*)(ws + WS_RB))[((size_t)l * 2 + b) * NE + cx.tid] = t; }
    }
}

__device__ __forceinline__ void hgrn_gates(const unsigned (&fw)[8]  , const f32x2 lb, LAS float* tot, int e, int lane,
                                           f32x2 (&G)[8], f32x2 (&kf)[8], f32x2 (&pre)[9]) {
    f32x2 run = (f32x2){0.f, 0.f}; const f32x2 oml = 1.0f - lb;
#pragma unroll
    for (int j = 0; j < 8; ++j) { f32x2 f = v2bf(fw[j]); f.x = fmaxf(f.x, -60.f); f.y = fmaxf(f.y, -60.f);
        const f32x2 en = v2exp2(f * (-LOG2E)), sg = v2rcp((f32x2){en.x + 1.0f, en.y + 1.0f});
        run += v2log2(lb + oml * sg);
        kf[j] = oml * en * sg;
        G[j] = run; }
    *(LAS f32x2*)(tot + e * 128 + 2 * lane) = run;
    __syncthreads();
    pre[0] = (f32x2){0.f, 0.f};
#pragma unroll
    for (int k = 0; k < 8; ++k) pre[k + 1] = pre[k] + *(const LAS f32x2*)(tot + k * 128 + 2 * lane);
    f32x2 off = (f32x2){0.f, 0.f};
#pragma unroll
    for (int k = 0; k < 8; ++k) if (k == e) off = pre[k];
#pragma unroll
    for (int j = 0; j < 8; ++j) G[j] += off;
}
__device__ __forceinline__ void load_words8(unsigned (&w)[8], const bf16_t* ubase  , unsigned voff  ) {
#pragma unroll
    for (int j = 0; j < 8; ++j) w[j] = *(const unsigned*)((const char*)(ubase + (size_t)j * NPO) + voff);
}
__device__ __forceinline__ void pack_t8(const unsigned (&w)[8], u32x4& lo, u32x4& hi) {
    lo.x = (w[0] & 0xffffu) | (w[1] << 16); lo.y = (w[2] & 0xffffu) | (w[3] << 16); lo.z = (w[4] & 0xffffu) | (w[5] << 16); lo.w = (w[6] & 0xffffu) | (w[7] << 16);
    hi.x = (w[0] >> 16) | (w[1] & 0xffff0000u); hi.y = (w[2] >> 16) | (w[3] & 0xffff0000u); hi.z = (w[4] >> 16) | (w[5] & 0xffff0000u); hi.w = (w[6] >> 16) | (w[7] & 0xffff0000u);
}
#define MFMA16(a, b, c) __builtin_amdgcn_mfma_f32_16x16x32_bf16((a), (b), (c), 0, 0, 0)

constexpr float ST8_SCALE = 4.0f;
__device__ __forceinline__ void phase_hgrn_local(const Params& p, LAS unsigned char* ldsb, int l) {
    const Ctx cx = make_ctx(ldsb);
    unsigned char* ws = launder(p.ws);
    const bf16_t* PROJ = (const bf16_t*)(ws + WS_PROJ);
    const float* LB = (const float*)(ws + WS_LB) + l * 512;
    bf16_t* SEGS = (bf16_t*)(ws + WS_U); float* SEGD = (float*)(ws + WS_SEGD); float* DEC = (float*)(ws + WS_DEC); unsigned char* ST = (unsigned char*)(ws + WS_S);
    constexpr int KH_OFF = 0, VT_OFF = 18432, TOT_OFF = 36864, DN_OFF = 40960, RS = 144;
    LAS unsigned char* lds = cx.lds; LAS float* tot = (LAS float*)(lds + TOT_OFF); LAS float* dnl = (LAS float*)(lds + DN_OFF);
    const int e = cx.wave, lane = cx.lane, r = lane & 15, g = lane >> 4;
    constexpr int SL_OFF = 45056, SLS = 144;
#define HL_STORE_TILE(uid_) do { unsigned char* sb_ = ST + (size_t)(uid_) * (DK * DK) + 1024 * e; const unsigned lo_ = 16u * (unsigned)lane; _Pragma("unroll") for (int h2 = 0; h2 < 2; ++h2) \
        *(u32x4*)(sb_ + 8192 * h2 + lo_) = *(const LAS u32x4*)(lds + SL_OFF + 1152 * e + 64 * SLS * h2 + lo_ + 16u * ((unsigned)lane >> 3)); } while (0)
    for (int seg = cx.bid; seg < NUNIT / 8; seg += cx.G) {
        const int bh = seg >> 5, b = bh >> 2, h = bh & 3;
        const f32x2 lb = *(const f32x2*)(LB + 128 * h + 2 * lane);
        const int mb = e >> 1, nb = e & 1;
        f32x4 acc[2][4];
#pragma unroll
        for (int mi = 0; mi < 2; ++mi)
#pragma unroll
            for (int ni = 0; ni < 4; ++ni) acc[mi][ni] = (f32x4){0.f, 0.f, 0.f, 0.f};
        f32x2 cum = (f32x2){0.f, 0.f};
        asm volatile("" : "+v"(cum));
        const bf16_t* base0 = PROJ + ((size_t)b * SEQ + (size_t)(seg & 31) * 8 * CHUNK + 8 * e) * NPO + 128 * h;
        const unsigned lvo = 4u * (unsigned)lane;
        unsigned fw[8], vw[8];
        load_words8(fw, base0 + PC_F, lvo); load_words8(vw, base0 + PC_I, lvo);
        for (int j = 0; j < 8; ++j) {
            const int uid = seg * 8 + j;
            f32x2 G[8], kf[8], pre[9];
            hgrn_gates(fw, lb, tot, e, lane, G, kf, pre);
            if (j > 0) HL_STORE_TILE(uid - 1);
            { unsigned w[8];
#pragma unroll
              for (int q = 0; q < 8; ++q) w[q] = pk2v(kf[q] * v2exp2(pre[8] - G[q]));
              u32x4 lo, hi; pack_t8(w, lo, hi);
              *(LAS u32x4*)(lds + KH_OFF + (2 * lane) * RS + 16 * e) = lo; *(LAS u32x4*)(lds + KH_OFF + (2 * lane + 1) * RS + 16 * e) = hi; }
            { u32x4 lo, hi; pack_t8(vw, lo, hi);
              *(LAS u32x4*)(lds + VT_OFF + (2 * lane) * RS + 16 * e) = lo; *(LAS u32x4*)(lds + VT_OFF + (2 * lane + 1) * RS + 16 * e) = hi; }
            if (e == 0) { *(f32x2*)(DEC + (size_t)uid * DK + 2 * lane) = v2exp2(cum);
                          *(LAS f32x2*)(dnl + 2 * lane) = v2exp2(pre[8]); }
            cum += pre[8];
            if (j < 7) { const bf16_t* bn = base0 + (size_t)(j + 1) * CHUNK * NPO; load_words8(fw, bn + PC_F, lvo); load_words8(vw, bn + PC_I, lvo); }
            __syncthreads();
            {
#pragma unroll
              for (int mi = 0; mi < 2; ++mi) { const f32x4 dn = *(const LAS f32x4*)(dnl + 32 * mb + 16 * mi + 4 * g);
#pragma unroll
                  for (int ni = 0; ni < 4; ++ni) { const f32x4 a = acc[mi][ni]; const f32x4 a4 = a * ST8_SCALE;
                      int w = __builtin_amdgcn_cvt_pk_fp8_f32(a4.x, a4.y, 0, false); w = __builtin_amdgcn_cvt_pk_fp8_f32(a4.z, a4.w, w, true);
                      *(LAS int*)(lds + SL_OFF + (64 * nb + 16 * ni + r) * SLS + 32 * mb + 16 * mi + 4 * g) = w;
                      acc[mi][ni] = a * dn; } } }
#pragma unroll
            for (int ks = 0; ks < 2; ++ks) {
                bf16x8 a[2], bb[4];
#pragma unroll
                for (int mi = 0; mi < 2; ++mi) a[mi] = *(const LAS bf16x8*)(lds + KH_OFF + (32 * mb + 16 * mi + r) * RS + (32 * ks + 8 * g) * 2);
#pragma unroll
                for (int ni = 0; ni < 4; ++ni) bb[ni] = *(const LAS bf16x8*)(lds + VT_OFF + (64 * nb + 16 * ni + r) * RS + (32 * ks + 8 * g) * 2);
#pragma unroll
                for (int mi = 0; mi < 2; ++mi)
#pragma unroll
                    for (int ni = 0; ni < 4; ++ni) acc[mi][ni] = MFMA16(a[mi], bb[ni], acc[mi][ni]);
            }
        }
        __syncthreads();
        HL_STORE_TILE(seg * 8 + 7);
        { bf16_t* ub = SEGS + (size_t)seg * (DK * DK);
#pragma unroll
          for (int mi = 0; mi < 2; ++mi)
#pragma unroll
              for (int ni = 0; ni < 4; ++ni) { const f32x4 a = acc[mi][ni]; u32x2 w;
                  w.x = bf_rne(a.x) | (bf_rne(a.y) << 16); w.y = bf_rne(a.z) | (bf_rne(a.w) << 16);
                  *(u32x2*)(ub + (size_t)(64 * nb + 16 * ni + r) * DK + 32 * mb + 16 * mi + 4 * g) = w; }
          if (e == 0) *(f32x2*)(SEGD + (size_t)seg * DK + 2 * lane) = v2exp2(cum); }
    }
#undef HL_STORE_TILE
    {
        unsigned char* Y = (unsigned char*)(ws + WS_Y);
        const float* cw = p.conv_w + (size_t)l * 3 * 512 + 8 * lane; const float* cg = p.conv_norm_g + (size_t)l * 512 + 8 * lane;
        float w0[8], w1[8], w2[8], gn[8];
#pragma unroll
        for (int i = 0; i < 8; ++i) { w0[i] = cw[i]; w1[i] = cw[512 + i]; w2[i] = cw[1024 + i]; gn[i] = cg[i]; }
        for (int run = cx.gw; run < NTOK / 8; run += cx.NGW) {
            const int t0 = run * 8; const bool first = (t0 & (SEQ - 1)) == 0;
            u32x4 uw[10], cb[8];
#pragma unroll
            for (int i = 0; i < 10; ++i) { const size_t t = (size_t)(first && i < 2 ? t0 : t0 - 2 + i);
                uw[i] = *(const u32x4*)(PROJ + t * NPO + PC_U + 8 * lane); }
#pragma unroll
            for (int i = 0; i < 8; ++i) cb[i] = *(const u32x4*)(PROJ + (size_t)(t0 + i) * NPO + PC_CB + 8 * lane);
            float um2[8], um1[8];
#pragma unroll
            for (int q = 0; q < 4; ++q) { um2[2 * q] = first ? 0.f : bflo(uw[0][q]); um2[2 * q + 1] = first ? 0.f : bfhi(uw[0][q]);
                um1[2 * q] = first ? 0.f : bflo(uw[1][q]); um1[2 * q + 1] = first ? 0.f : bfhi(uw[1][q]); }
#pragma unroll
            for (int i = 0; i < 8; ++i) { const size_t t = (size_t)(t0 + i);
                float u[8], y[8], ss = 0.f;
#pragma unroll
                for (int q = 0; q < 4; ++q) { u[2 * q] = bflo(uw[i + 2][q]); u[2 * q + 1] = bfhi(uw[i + 2][q]); }
#pragma unroll
                for (int q = 0; q < 4; ++q) { y[2 * q] = bflo(cb[i][q]) * (w0[2 * q] * um2[2 * q] + w1[2 * q] * um1[2 * q] + w2[2 * q] * u[2 * q]);
                    y[2 * q + 1] = bfhi(cb[i][q]) * (w0[2 * q + 1] * um2[2 * q + 1] + w1[2 * q + 1] * um1[2 * q + 1] + w2[2 * q + 1] * u[2 * q + 1]); }
#pragma unroll
                for (int q = 0; q < 8; ++q) ss += y[q] * y[q];
                ss = oct_sum(ss);
                const float rstd = frsq(ss * (1.0f / 64.0f) + RMS_EPS);
                float o8[8];
#pragma unroll
                for (int q = 0; q < 8; ++q) o8[q] = y[q] * rstd * gn[q];
                *(u32x2*)(Y + t * D + 8 * lane) = pack8_fp8(o8);
#pragma unroll
                for (int q = 0; q < 8; ++q) { um2[q] = um1[q]; um1[q] = u[q]; }
            }
        }
    }
}

__device__ __forceinline__ void phase_hgrn_scan(const Params& p, LAS unsigned char* ldsb) {
    const Ctx cx = make_ctx(ldsb);
    unsigned char* ws = launder(p.ws);
    const bf16_t* SEGS = (const bf16_t*)(ws + WS_U); const float* SEGD = (const float*)(ws + WS_SEGD); const float* DEC = (const float*)(ws + WS_DEC); const unsigned char* ST = (const unsigned char*)(ws + WS_S); unsigned char* ST8 = (unsigned char*)(ws + WS_ST8);
    constexpr int NQ = NBATCH * NHEAD * DK * DK / 4, SCAN_T = 128;
    if (cx.tid >= SCAN_T) return;
    for (int q4 = cx.bid * SCAN_T + cx.tid; q4 < NQ; q4 += cx.G * SCAN_T) {
        const int eidx = 4 * q4, bh = eidx >> 14, rem = eidx & 16383, dk = rem & 127;
        const bf16_t* up = SEGS + (size_t)bh * 32 * (DK * DK) + rem; const float* dp = SEGD + (size_t)bh * 32 * DK + dk;
        const unsigned char* sp = ST + (size_t)bh * NCHUNK * (DK * DK) + rem; unsigned char* sq = ST8 + (size_t)bh * NCHUNK * (DK * DK) + rem; const float* pp = DEC + (size_t)bh * NCHUNK * DK + dk;
        f32x4 S = (f32x4){0.f, 0.f, 0.f, 0.f};
        for (int sg = 0; sg < 32; sg += 2) {
            u32x2 uw[2]; f32x4 d[2], pn[16]; unsigned sv[16];
#pragma unroll
            for (int i = 0; i < 2; ++i) { uw[i] = *(const u32x2*)(up + (size_t)(sg + i) * (DK * DK)); d[i] = *(const f32x4*)(dp + (size_t)(sg + i) * DK); }
#pragma unroll
            for (int i = 0; i < 16; ++i) { sv[i] = *(const unsigned*)(sp + (size_t)(sg * 8 + i) * (DK * DK)); pn[i] = *(const f32x4*)(pp + (size_t)(sg * 8 + i) * DK); }
#pragma unroll
            for (int i = 0; i < 2; ++i) {
#pragma unroll
                for (int j = 0; j < 8; ++j) { const int w = (int)sv[i * 8 + j];
                    const f32x2 lo = __builtin_amdgcn_cvt_pk_f32_fp8(w, false), hi = __builtin_amdgcn_cvt_pk_f32_fp8(w, true);
                    const f32x4 v = (f32x4){lo.x, lo.y, hi.x, hi.y} + pn[i * 8 + j] * S * ST8_SCALE;
                    int o = __builtin_amdgcn_cvt_pk_fp8_f32(v.x, v.y, 0, false); o = __builtin_amdgcn_cvt_pk_fp8_f32(v.z, v.w, o, true);
                    *(int*)(sq + (size_t)((sg + i) * 8 + j) * (DK * DK)) = o; }
                const f32x4 u = (f32x4){bflo(uw[i].x), bfhi(uw[i].x), bflo(uw[i].y), bfhi(uw[i].y)};
                S = d[i] * S + u; }
        }
    }
}

__device__ __forceinline__ void phase_hgrn_out(const Params& p, LAS unsigned char* ldsb, int l) {
    const Ctx cx = make_ctx(ldsb);
    unsigned char* ws = launder(p.ws);
    const bf16_t* PROJ = (const bf16_t*)(ws + WS_PROJ); const unsigned char* ST8 = (const unsigned char*)(ws + WS_ST8); unsigned char* Y = (unsigned char*)(ws + WS_Y);
    const float* LB = (const float*)(ws + WS_LB) + l * 512;
    constexpr int QH_OFF = 0, QT_OFF = 17408, KT_OFF = 34816, VT_OFF = 78336, P_OFF = 96768, TOT_OFF = 105984, QP_OFF = 110080, RQ = 272, RS = 144, OL_OFF = KT_OFF, OLS = 132;
    LAS unsigned char* lds = cx.lds; LAS float* tot = (LAS float*)(lds + TOT_OFF);
    const int e = cx.wave, lane = cx.lane, r = lane & 15, g = lane >> 4;
    for (int seg = cx.bid; seg < NUNIT / 8; seg += cx.G) {
        const int bh = seg >> 5, b = bh >> 2, h = bh & 3;
        const f32x2 lb = *(const f32x2*)(LB + 128 * h + 2 * lane);
        const f32x2 gnv = *(const f32x2*)(p.hgrn_norm_g + (size_t)l * 512 + 128 * h + 2 * lane);
        const bf16_t* base0 = PROJ + ((size_t)b * SEQ + (size_t)(seg & 31) * 8 * CHUNK + 8 * e) * NPO + 128 * h;
        const unsigned lvo = 4u * (unsigned)lane;
        unsigned fw[8], qw[8], vw[8];
        load_words8(fw, base0 + PC_F, lvo); load_words8(qw, base0 + PC_Q, lvo); load_words8(vw, base0 + PC_I, lvo);
        const int it = e & 3, nb = e >> 2; f32x4 acc[4];
        for (int jc = 0; jc < 8; ++jc) {
        const int uid = seg * 8 + jc;
        const size_t row0 = (size_t)b * SEQ + (size_t)((seg & 31) * 8 + jc) * CHUNK;
        u32x4 sraw[4][2];
        { const unsigned char* sb = ST8 + (size_t)uid * (DK * DK);
#pragma unroll
          for (int ni = 0; ni < 4; ++ni)
#pragma unroll
              for (int hh = 0; hh < 2; ++hh) sraw[ni][hh] = *(const u32x4*)(sb + (size_t)(64 * nb + 16 * ni + r) * DK + 32 * g + 16 * hh); }
        f32x2 G[8], kf[8], pre[9];
        hgrn_gates(fw, lb, tot, e, lane, G, kf, pre);
        const int isub = e >> 1;
        f32x2 R[4];
#pragma unroll
        for (int i = 0; i < 4; ++i) R[i] = pre[2 * i];
        f32x2 Ri = (f32x2){0.f, 0.f};
#pragma unroll
        for (int i = 0; i < 4; ++i) if (i == isub) Ri = R[i];
        { const f32x2 eR = v2exp2(Ri);
#pragma unroll
          for (int j = 0; j < 8; ++j) { const f32x2 q = v2bf(qw[j]); const int t = 8 * e + j;
            const f32x2 sq = q * v2rcp(v2exp2(q * (-LOG2E)) + 1.0f);
            const f32x2 tq = sq * v2exp2(G[j] - Ri);
            *(LAS unsigned*)(lds + QT_OFF + t * RQ + 4 * lane) = pk2v(tq);
            *(LAS unsigned*)(lds + QH_OFF + t * RQ + 4 * lane) = pk2v(tq * eR); } }
        { f32x2 kd[8];
#pragma unroll
          for (int j = 0; j < 8; ++j) { f32x2 x = Ri - G[j]; x.x = fminf(x.x, 115.f); x.y = fminf(x.y, 115.f); kd[j] = kf[j] * v2exp2(x); }
#pragma unroll
          for (int i = 0; i < 4; ++i) if (i >= isub) { const f32x2 fc = v2exp2(R[i] - Ri);
#pragma unroll
              for (int j = 0; j < 8; ++j) { const int t = 8 * e + j;
                  *(LAS unsigned*)(lds + KT_OFF + (8 * i * (i + 1) + t) * RQ + 4 * lane) = pk2v(kd[j] * fc); } } }
        { u32x4 lo, hi; pack_t8(vw, lo, hi);
          *(LAS u32x4*)(lds + VT_OFF + (2 * lane) * RS + 16 * e) = lo; *(LAS u32x4*)(lds + VT_OFF + (2 * lane + 1) * RS + 16 * e) = hi; }
        if (jc < 7) { const bf16_t* bn = base0 + (size_t)(jc + 1) * CHUNK * NPO; load_words8(fw, bn + PC_F, lvo); load_words8(qw, bn + PC_Q, lvo); load_words8(vw, bn + PC_I, lvo); }
        unsigned ogw[8];
        load_words8(ogw, base0 + (size_t)jc * CHUNK * NPO + PC_OG, lvo);
        __syncthreads();
        { const int i = e >> 1;
#pragma unroll
          for (int jx = 0; jx < 2; ++jx) { const int j = 2 * (e & 1) + jx; f32x4 acc = (f32x4){0.f, 0.f, 0.f, 0.f};
              if (j <= i) {
#pragma unroll
                  for (int ks = 0; ks < 4; ++ks) { const bf16x8 a = *(const LAS bf16x8*)(lds + QT_OFF + (16 * i + r) * RQ + (32 * ks + 8 * g) * 2);
                      const bf16x8 bb = *(const LAS bf16x8*)(lds + KT_OFF + (8 * i * (i + 1) + 16 * j + r) * RQ + (32 * ks + 8 * g) * 2);
                      acc = MFMA16(a, bb, acc); } }
#pragma unroll
              for (int reg = 0; reg < 4; ++reg) { const int tl = 4 * g + reg; const float v = (j < i || (j == i && r <= tl)) ? acc[reg] : 0.f;
                  *(LAS bf16_t*)(lds + P_OFF + (16 * i + tl) * RS + (16 * j + r) * 2) = (bf16_t)f2bf(v); } } }
#pragma unroll
        for (int ni = 0; ni < 4; ++ni) acc[ni] = (f32x4){0.f, 0.f, 0.f, 0.f};
#pragma unroll
        for (int ks = 0; ks < 4; ++ks) { const bf16x8 a = *(const LAS bf16x8*)(lds + QH_OFF + (16 * it + r) * RQ + (32 * g + 8 * ks) * 2);
#pragma unroll
            for (int ni = 0; ni < 4; ++ni) { const u32x4 q4 = sraw[ni][ks >> 1]; const int w0 = (ks & 1) ? (int)q4.z : (int)q4.x, w1 = (ks & 1) ? (int)q4.w : (int)q4.y;
                u32x4 fb;
                fb.x = __builtin_bit_cast(unsigned, __builtin_amdgcn_cvt_scalef32_pk_bf16_fp8(w0, 1.0f / ST8_SCALE, false)); fb.y = __builtin_bit_cast(unsigned, __builtin_amdgcn_cvt_scalef32_pk_bf16_fp8(w0, 1.0f / ST8_SCALE, true));
                fb.z = __builtin_bit_cast(unsigned, __builtin_amdgcn_cvt_scalef32_pk_bf16_fp8(w1, 1.0f / ST8_SCALE, false)); fb.w = __builtin_bit_cast(unsigned, __builtin_amdgcn_cvt_scalef32_pk_bf16_fp8(w1, 1.0f / ST8_SCALE, true));
                acc[ni] = MFMA16(a, __builtin_bit_cast(bf16x8, fb), acc[ni]); } }
        __syncthreads();
        {
#pragma unroll
          for (int ks = 0; ks < 2; ++ks) { const bf16x8 a = *(const LAS bf16x8*)(lds + P_OFF + (16 * it + r) * RS + (32 * ks + 8 * g) * 2);
#pragma unroll
              for (int ni = 0; ni < 4; ++ni) { const bf16x8 bb = *(const LAS bf16x8*)(lds + VT_OFF + (64 * nb + 16 * ni + r) * RS + (32 * ks + 8 * g) * 2); acc[ni] = MFMA16(a, bb, acc[ni]); } }
#pragma unroll
          for (int ni = 0; ni < 4; ++ni)
#pragma unroll
              for (int reg = 0; reg < 4; ++reg) *(LAS float*)(lds + OL_OFF + ((16 * it + 4 * g + reg) * OLS + 64 * nb + 16 * ni + r) * 4) = acc[ni][reg];
        }
        __syncthreads();
        {
#pragma unroll
          for (int j = 0; j < 8; ++j) { const int t = 8 * e + j; const f32x2 o = *(const LAS f32x2*)(lds + OL_OFF + (t * OLS + 2 * lane) * 4);
              const float ss = wave_sum(o.x * o.x + o.y * o.y); const float rstd = frsq(ss * (1.0f / 128.0f) + RMS_EPS);
              const f32x2 og = v2bf(ogw[j]); const f32x2 y = o * rstd * gnv * (og * v2rcp(v2exp2(og * (-LOG2E)) + 1.0f));
              *(unsigned short*)(Y + (row0 + t) * D + 512 + 128 * h + 2 * lane) = (unsigned short)__builtin_amdgcn_cvt_pk_fp8_f32(y.x, y.y, 0, false); } }
        }
    }
}

__device__ __forceinline__ void phase_router(const Params& p, LAS unsigned char* ldsb, int l, int dummy = 0) {
    const Ctx cx = make_ctx(ldsb);
    unsigned char* ws = launder(p.ws);
    const bf16_t* X1 = (const bf16_t*)(ws + WS_X1); unsigned char* HN8 = (unsigned char*)(ws + WS_HN8);
    const float* ada = (const float*)(ws + WS_ADA) + (size_t)l * 2 * 6 * D;
    int* LISTA = (int*)(ws + WS_LISTA + (dummy ? ((size_t)64 << 20) : 0)); float* TOKGATE = (float*)(ws + WS_TOKGATE);
    unsigned* gcnt = (unsigned*)(ws + WS_CTL) + CW_CNT + 64 * (l + (dummy ? DEPTH : 0));
    LAS f32x4* wl = (LAS f32x4*)cx.lds;
    LAS int* lcnt = (LAS int*)(cx.lds + MISC_OFF + MS_LCNT); LAS int* gbase = (LAS int*)(cx.lds + MISC_OFF + MS_GBASE);
    const int lane = cx.lane, r = lane & 15, g = lane >> 4;
    const float* gn = p.norm2_g + (size_t)l * D;
    int cur_b = -1;
    for (int chunk = cx.bid; chunk < NTOK / 128; chunk += cx.G) {
        const int b = (chunk * 128) / SEQ;
        const float* sh = ada + (size_t)b * 6 * D + 3 * D; const float* sc = ada + (size_t)b * 6 * D + 4 * D;
        const int tok0 = chunk * 128 + cx.wave * 16;
        const bf16_t* xp = X1 + (size_t)(tok0 + r) * D + 8 * g;
        u32x4 xwa[16], xwb[16];
#pragma unroll
        for (int u = 0; u < 16; ++u) xwa[u] = *(const u32x4*)(xp + 32 * u);
        if (b != cur_b) {
            __syncthreads();
            const f32x4* WLG = (const f32x4*)(ws + WS_WL) + ((size_t)l * 2 + b) * 8192;
            f32x4 wv[16];
#pragma unroll
            for (int i = 0; i < 16; ++i) wv[i] = WLG[cx.tid + 512 * i];
#pragma unroll
            for (int i = 0; i < 16; ++i) wl[cx.tid + 512 * i] = wv[i];
            cur_b = b;
        }
        if (cx.tid < NE) lcnt[cx.tid] = 0;
        __syncthreads();
        f32x4 acc0 = (f32x4){0.f, 0.f, 0.f, 0.f}, acc1 = (f32x4){0.f, 0.f, 0.f, 0.f}; float ss = 0.f;
        { const LAS bf16x8* wlb = (const LAS bf16x8*)cx.lds;
#pragma unroll
          for (int u = 0; u < 16; ++u) xwb[u] = *(const u32x4*)(xp + 32 * (16 + u));
#pragma unroll
          for (int hb = 0; hb < 2; ++hb)
#pragma unroll
              for (int u = 0; u < 16; ++u) { const u32x4 xq = hb == 0 ? xwa[u] : xwb[u]; float xv[8]; unpack8(xq, xv);
#pragma unroll
                  for (int i = 0; i < 8; ++i) ss += xv[i] * xv[i];
                  const bf16x8 xa = __builtin_bit_cast(bf16x8, xq); const int fb = (16 * hb + u) * 256 + lane;
                  acc0 = MFMA16(xa, wlb[fb], acc0); acc1 = MFMA16(xa, wlb[fb + 128], acc1);
                  acc0 = MFMA16(xa, wlb[fb + 64], acc0); acc1 = MFMA16(xa, wlb[fb + 192], acc1); } }
        ss += __shfl_xor(ss, 16); ss += __shfl_xor(ss, 32);
        const float rstd = frsq(ss * (1.0f / D) + RMS_EPS);
        const float* RB = (const float*)(ws + WS_RB) + ((size_t)l * 2 + b) * NE; const float rb0 = RB[r], rb1 = RB[16 + r];
        int es = 0; float gs = 0.f;
#pragma unroll
        for (int reg = 0; reg < 4; ++reg) {
            const float rs = __shfl(rstd, 4 * g + reg);
            float v0 = acc0[reg] * rs + rb0, v1 = acc1[reg] * rs + rb1;
            float tv[4]; int ti[4];
#pragma unroll
            for (int k = 0; k < 4; ++k) { const bool up = v1 > v0; float bv = up ? v1 : v0; int bi = up ? 16 + r : r;
#define RT_STEP(CTRL) do { const float ov = dpp_f<CTRL>(bv); const int oi = dpp_i<CTRL>(bi); const bool take = ov > bv || (ov == bv && oi < bi); bv = take ? ov : bv; bi = take ? oi : bi; } while (0)
                RT_STEP(0xB1); RT_STEP(0x4E); RT_STEP(0x141); RT_STEP(0x140);
#undef RT_STEP
                tv[k] = bv; ti[k] = bi; v0 = (bi == r) ? -3.0e38f : v0; v1 = (bi == 16 + r) ? -3.0e38f : v1; }
            const float e1 = __expf(tv[1] - tv[0]), e2 = __expf(tv[2] - tv[0]), e3 = __expf(tv[3] - tv[0]); const float inv = 1.0f / (1.0f + e1 + e2 + e3);
            if ((r >> 2) == reg) { const int k = r & 3; es = k == 0 ? ti[0] : k == 1 ? ti[1] : k == 2 ? ti[2] : ti[3]; gs = (k == 0 ? 1.0f : k == 1 ? e1 : k == 2 ? e2 : e3) * inv; }
        }
        const int lp = __hip_atomic_fetch_add(lcnt + es, 1, __ATOMIC_RELAXED, __HIP_MEMORY_SCOPE_WORKGROUP);
        __syncthreads();
        unsigned gb = 0u; if (cx.tid < NE) gb = atomicAdd(gcnt + cx.tid, (unsigned)lcnt[cx.tid]);
        { float a8[2][8], s8[2][8];
#pragma unroll
          for (int j = 0; j < 2; ++j)
#pragma unroll
              for (int h = 0; h < 2; ++h) { const int c = 8 * lane + 512 * j + 4 * h; const f32x4 gg4 = *(const f32x4*)(gn + c), sc4 = *(const f32x4*)(sc + c), sh4 = *(const f32x4*)(sh + c);
#pragma unroll
                  for (int i = 0; i < 4; ++i) { a8[j][4 * h + i] = gg4[i] * (sc4[i] + 1.0f); s8[j][4 * h + i] = sh4[i]; } }
          for (int i0 = 0; i0 < 16; i0 += 4) { u32x4 xw[4][2];
#pragma unroll
              for (int u = 0; u < 4; ++u)
#pragma unroll
                  for (int j = 0; j < 2; ++j) xw[u][j] = *(const u32x4*)(X1 + (size_t)(tok0 + i0 + u) * D + 8 * lane + 512 * j);
#pragma unroll
              for (int u = 0; u < 4; ++u) { const float rs = __shfl(rstd, i0 + u);
#pragma unroll
                  for (int j = 0; j < 2; ++j) { float xv[8], o[8]; unpack8(xw[u][j], xv);
#pragma unroll
                      for (int i = 0; i < 8; ++i) o[i] = (xv[i] * rs) * a8[j][i] + s8[j][i];
                      *(u32x2*)(HN8 + (size_t)(tok0 + i0 + u) * D + 8 * lane + 512 * j) = pack8_fp8(o); } } } }
        if (cx.tid < NE) gbase[cx.tid] = (int)gb;
        __syncthreads();
        { const int pos = gbase[es] + lp; LISTA[(size_t)es * NASSIGN + pos] = chunk * 512 + cx.tid; TOKGATE[(size_t)chunk * 512 + cx.tid] = gs; }
    }
}

__device__ __forceinline__ void build_expert_tables(const Params& p, const Ctx& cx, int l) {
    const unsigned* gcnt = (const unsigned*)(launder(p.ws) + WS_CTL) + CW_CNT + 64 * l;
    LAS int* pstart = (LAS int*)(cx.lds + MISC_OFF + MS_PSTART); LAS int* cnt = (LAS int*)(cx.lds + MISC_OFF + MS_CNT);
    LAS unsigned char* blke = (LAS unsigned char*)(cx.lds + MISC_OFF + MS_BLKE); LAS int* nm = (LAS int*)(cx.lds + MISC_OFF + MS_NM);
    if (cx.tid < NE) cnt[cx.tid] = (int)gcnt[cx.tid];
    __syncthreads();
    if (cx.tid == 0) { int run = 0; for (int e = 0; e < NE; ++e) { pstart[e] = run; run += (cnt[e] + 255) & ~255; } pstart[NE] = run; nm[0] = run >> 8; }
    __syncthreads();
    if (cx.tid < NE) { const int b0 = pstart[cx.tid] >> 8, b1 = pstart[cx.tid + 1] >> 8; for (int b = b0; b < b1; ++b) blke[b] = (unsigned char)cx.tid; }
    __syncthreads();
}

__device__ __forceinline__ int bias_tab_off(int ui) { return ui < 16 ? BIAS_OFF + ui * 512 : IDX_OFF + 17 * 512 + (ui - 16) * 512; }
template <bool WANT_TOK, class Sched>
__device__ __forceinline__ bool build_row_tables(const Ctx& cx, const Sched& S, unsigned char* ws, const float* bias_l) {
    LAS int* pstart = (LAS int*)(cx.lds + MISC_OFF + MS_PSTART); LAS int* cnt = (LAS int*)(cx.lds + MISC_OFF + MS_CNT);
    LAS int* udesc = (LAS int*)(cx.lds + MISC_OFF + MS_LE);
    LAS int* nun = (LAS int*)(cx.lds + MISC_OFF + MS_LPOS);
    const int* LISTA = (const int*)(ws + WS_LISTA);
    constexpr int MU = WANT_TOK ? MAXU : MAXU / 2;
    if (cx.tid < MAXU) { pg8::Unit u; int base = 0, nv = -1, ue = 0, upn = 0;
        if (S.next(cx.tid, u)) { const int pos0 = (u.pm - (pstart[u.e] >> 8)) * 256; base = u.e * NASSIGN + pos0; nv = cnt[u.e] - pos0; nv = nv > 256 ? 256 : nv; ue = u.e; upn = u.pn; }
        udesc[4 * cx.tid] = base; udesc[4 * cx.tid + 1] = nv; udesc[4 * cx.tid + 2] = ue; udesc[4 * cx.tid + 3] = upn; }
    if (cx.tid == 0) { pg8::Unit u; nun[0] = S.next(WANT_TOK ? 17 : MU, u) ? 1 : 0; }
    __syncthreads();
    const bool ok = nun[0] == 0;
    const int r = cx.tid & 255, u0 = cx.tid >> 8;
    int v[MU / 2]; float bvv[MU / 2];
#pragma unroll
    for (int k = 0; k < MU / 2; ++k) { const int ui = 2 * k + u0, nv = udesc[4 * ui + 1], ue = udesc[4 * ui + 2], upn = udesc[4 * ui + 3];
        v[k] = (nv >= 0 && r < nv) ? LISTA[udesc[4 * ui] + r] : -1;
        bvv[k] = nv >= 0 ? (WANT_TOK ? bias_l[(size_t)ue * 2048 + (r < 128 ? 128 * upn + r : 1024 + 128 * upn + (r - 128))] : bias_l[(size_t)ue * D + 256 * upn + r]) : 0.f; }
#pragma unroll
    for (int k = 0; k < MU / 2; ++k) { const int ui = 2 * k + u0;
        if (udesc[4 * ui + 1] >= 0) {
            if (WANT_TOK) ((LAS unsigned short*)(cx.lds + IDX_OFF))[ui * 256 + r] = (unsigned short)(v[k] >= 0 ? (v[k] >> 2) : NTOK);
            else ((LAS int*)(cx.lds + IDX_OFF))[ui * 256 + r] = v[k];
            *(LAS bf16_t*)(cx.lds + bias_tab_off(ui) + 2 * r) = (bf16_t)f2bf(bvv[k]); } }
    __syncthreads();
    return ok;
}

constexpr int CROWS = 4;
__device__ __forceinline__ void phase_combine(const Params& p, LAS unsigned char* ldsb, int l, bool poison) {
    const Ctx cx = make_ctx(ldsb);
    unsigned char* ws = launder(p.ws);
    const bf16_t* X1 = (const bf16_t*)(ws + WS_X1); bf16_t* X0 = (bf16_t*)(ws + WS_X0); const unsigned char* SLOT = (const unsigned char*)(ws + WS_SLOT); bf16_t* HN = (bf16_t*)(ws + WS_HN);
    const float* TOKGATE = (const float*)(ws + WS_TOKGATE);
    const float* ada = (const float*)(ws + WS_ADA) + (size_t)l * 2 * 6 * D;
    const float* adan = (const float*)(ws + WS_ADA) + (size_t)(l + 1) * 2 * 6 * D;
    const int lane = cx.lane;
    for (int row0 = CROWS * cx.gw; row0 < NTOK; row0 += CROWS * cx.NGW) {
        const int b = row0 / SEQ; const float* g2 = ada + (size_t)b * 6 * D + 5 * D;
        u32x4 xw[CROWS][2]; u32x2 sw[CROWS][2][4];
        f32x4 gt[CROWS];
#pragma unroll
        for (int u = 0; u < CROWS; ++u) gt[u] = *(const f32x4*)(TOKGATE + (size_t)(row0 + u) * 4);
#pragma unroll
        for (int u = 0; u < CROWS; ++u)
#pragma unroll
            for (int j = 0; j < 2; ++j) { const int c = 8 * lane + 512 * j;
                xw[u][j] = *(const u32x4*)(X1 + (size_t)(row0 + u) * D + c);
#pragma unroll
                for (int k = 0; k < 4; ++k) sw[u][j][k] = *(const u32x2*)(SLOT + ((size_t)(row0 + u) * 4 + k) * D + c); }
#pragma unroll
        for (int u = 0; u < CROWS; ++u) { const int row = row0 + u; float v[2][8];
#pragma unroll
            for (int j = 0; j < 2; ++j) { const int c = 8 * lane + 512 * j; float m[8], x[8];
#pragma unroll
                for (int i = 0; i < 8; ++i) m[i] = 0.f;
#pragma unroll
                for (int k = 0; k < 4; ++k) { float sv[8]; unpack8_fp8(sw[u][j][k], sv); const float gk = gt[u][k];
#pragma unroll
                    for (int i = 0; i < 8; ++i) m[i] += sv[i] * gk; }
                unpack8(xw[u][j], x);
                const f32x4 ga = *(const f32x4*)(g2 + c), gb = *(const f32x4*)(g2 + c + 4);
#pragma unroll
                for (int i = 0; i < 4; ++i) { v[j][i] = x[i] + ga[i] * m[i]; v[j][4 + i] = x[4 + i] + gb[i] * m[4 + i]; } }
            if (l < DEPTH - 1) {
#pragma unroll
                for (int j = 0; j < 2; ++j) *(u32x4*)(X0 + (size_t)row * D + 8 * lane + 512 * j) = pack8(v[j]);
                norm_mod_store8(v, p.norm1_g + (size_t)(l + 1) * D, adan + (size_t)b * 6 * D + 0 * D, adan + (size_t)b * 6 * D + 1 * D, HN + (size_t)row * D, lane);
            } else {
                float ss = 0.f;
#pragma unroll
                for (int j = 0; j < 2; ++j)
#pragma unroll
                    for (int i = 0; i < 8; ++i) ss += v[j][i] * v[j][i];
                const float rstd = frsq(wave_sum(ss) * (1.0f / D) + RMS_EPS);
#pragma unroll
                for (int j = 0; j < 2; ++j)
#pragma unroll
                    for (int h = 0; h < 2; ++h) { const int c = 8 * lane + 512 * j + 4 * h; const f32x4 fg = *(const f32x4*)(p.final_g + c);
                        f32x4 o = (f32x4){v[j][4 * h] * rstd * fg[0], v[j][4 * h + 1] * rstd * fg[1], v[j][4 * h + 2] * rstd * fg[2], v[j][4 * h + 3] * rstd * fg[3]};
                        if (poison) { const float q = __builtin_nanf(""); o = (f32x4){q, q, q, q}; }
                        *(f32x4*)(p.out + (size_t)row * D + c) = o; }
            }
        }
    }
}

constexpr int NPH = 2 + 9 * DEPTH;
__global__ void __launch_bounds__(512, 2) mk_fwd(Params p) {
    extern __shared__ __attribute__((aligned(16))) unsigned char lds_raw[];
    LAS unsigned char* const ldsb = (LAS unsigned char*)lds_raw;
    volatile LAS unsigned* barst = (volatile LAS unsigned*)(ldsb + MISC_OFF + MS_BAR);
    if (threadIdx.x < 4) barst[threadIdx.x] = 0u;
    __syncthreads();
    const int lo = p.ph_lo, hi = p.ph_hi;
    unsigned* barw = (unsigned*)(p.ws + WS_CTL) + CW_BAR;
    XcdBarrier bar; bar.bar = barw; bar.x = 0; bar.st = barst;
    if (hi - lo > 1) bar = xcd_barrier_post(barw, barst);
#define IN(k) (lo <= (k) && (k) < hi)
#define SEAM(k) do { if (IN(k) && IN((k) + 1)) xcd_barrier(bar); } while (0)

    if (IN(0)) for (int rep = 0; rep < REPS(0); ++rep) phase_prologue(p, ldsb);
    SEAM(0);
    if (IN(1)) for (int rep = 0; rep < REPS(1); ++rep) phase_norm1_first(p, ldsb);
    SEAM(1);
    for (int l = 0; l < DEPTH; ++l) {
        const int base = 2 + 9 * l;
        if (IN(base + 0)) for (int rep = 0; rep < REPS(2); ++rep) {
            const Ctx cx = make_ctx(ldsb); unsigned char* ws = launder(p.ws);
            pg8::Gemm g{(const bf16_t*)(ws + WS_HN), (const bf16_t*)(ws + WS_WIN) + (size_t)l * NPROJ * D, NTOK, NPROJ, D, 0};
            pg8::StaticOrder S; S.init(NTOK / 256, NPROJ, cx.G, cx.bid);
            pg8::EpiProj E{(bf16_t*)(ws + WS_PROJ)};
            const bool conv_first = ((cx.bid >> 3) & 1) != 0;
            if (conv_first && rep == 0) convert_expert_weights(p, cx, ws, l, 0);
            pg8::gemm_phase<pg8::EpiProj, pg8::StaticOrder>(cx.lds, g, S, E, cx.tid);
            if (!conv_first && rep == 0) convert_expert_weights(p, cx, ws, l, 0);
            if (rep == 0) convert_tail(p, cx, ws, l, 0);
        }
        SEAM(base + 0);
        if (IN(base + 1)) for (int rep = 0; rep < REPS(3); ++rep) phase_hgrn_local(p, ldsb, l);
        SEAM(base + 1);
        if (IN(base + 2)) for (int rep = 0; rep < REPS(4); ++rep) phase_hgrn_scan(p, ldsb);
        SEAM(base + 2);
        if (IN(base + 3)) for (int rep = 0; rep < REPS(5); ++rep) phase_hgrn_out(p, ldsb, l);
        SEAM(base + 3);
        if (IN(base + 4)) for (int rep = 0; rep < REPS(6); ++rep) {
            const Ctx cx = make_ctx(ldsb); unsigned char* ws = launder(p.ws);
            const float* ada_l = (const float*)(ws + WS_ADA) + (size_t)l * 2 * 6 * D;
            pg8::Gemm g{(const bf16_t*)(ws + WS_Y), (const bf16_t*)(ws + WS_WOUT + (size_t)l * D * D), NTOK, D, D / 2, 0};
            pg8::StaticOrder S; S.init(NTOK / 256, D, cx.G, cx.bid);
            if (l == 0) { pg8::EpiResidual<true> E{(const void*)p.x, (bf16_t*)(ws + WS_X1), ada_l + 2 * D, 1.0f / WGU_SCALE};
                pg8::gemm_phase<pg8::EpiResidual<true>, pg8::StaticOrder, true, true>(cx.lds, g, S, E, cx.tid, nullptr); }
            else { pg8::EpiResidual<false> E{(const void*)(ws + WS_X0), (bf16_t*)(ws + WS_X1), ada_l + 2 * D, 1.0f / WGU_SCALE};
                pg8::gemm_phase<pg8::EpiResidual<false>, pg8::StaticOrder, true, true>(cx.lds, g, S, E, cx.tid, nullptr); }
        }
        SEAM(base + 4);
        if (IN(base + 5)) for (int rep = 0; rep < REPS(7); ++rep) phase_router(p, ldsb, l, rep);
        SEAM(base + 5);
        if (IN(base + 6)) for (int rep = 0; rep < REPS(9); ++rep) {
            const Ctx cx = make_ctx(ldsb); unsigned char* ws = launder(p.ws);
            build_expert_tables(p, cx, l);
            const int nmb = *(LAS int*)(cx.lds + MISC_OFF + MS_NM);
            pg8::Gemm g{(const bf16_t*)(ws + WS_HN8), (const bf16_t*)(ws + WS_WGU + (size_t)l * NE * 2048 * D), nmb * 256, 2048, D / 2, (size_t)2048 * D};
            pg8::GroupedOrder S; S.init(nmb, 2048, cx.G, cx.bid); S.blk_e = (const LAS unsigned char*)(cx.lds + MISC_OFF + MS_BLKE);
            const bool conv_first = ((cx.bid >> 3) & 1) != 0;
            const int r_hi = (nmb * 8) % cx.G;
            if (conv_first && rep == 0) convert_expert_weights(p, cx, ws, l, 1, r_hi);
            if (build_row_tables<true>(cx, S, ws, p.b_gu + (size_t)l * NE * 2048)) {
                pg8::EpiGateUp E{(unsigned char*)(ws + WS_ACT), (const LAS unsigned char*)cx.lds, 1.0f / WGU_SCALE};
                pg8::gemm_phase<pg8::EpiGateUp, pg8::GroupedOrder, true, true>(cx.lds, g, S, E, cx.tid, (const LAS unsigned short*)(cx.lds + IDX_OFF));
            }
            if (!conv_first && rep == 0) convert_expert_weights(p, cx, ws, l, 1, r_hi);
            if (rep == 0) convert_tail(p, cx, ws, l, 1);
        }
        SEAM(base + 6);
        if (IN(base + 7)) for (int rep = 0; rep < REPS(10); ++rep) {
            const Ctx cx = make_ctx(ldsb); unsigned char* ws = launder(p.ws);
            build_expert_tables(p, cx, l);
            const int nmb = *(LAS int*)(cx.lds + MISC_OFF + MS_NM);
            pg8::Gemm g{(const bf16_t*)(ws + WS_ACT), (const bf16_t*)(ws + WS_WDN + (size_t)l * NE * D * D), nmb * 256, D, D / 2, (size_t)D * D};
            pg8::GroupedOrder S; S.init(nmb, D, cx.G, cx.bid); S.blk_e = (const LAS unsigned char*)(cx.lds + MISC_OFF + MS_BLKE);
            if (build_row_tables<false>(cx, S, ws, p.b_down + (size_t)l * NE * D)) {
                pg8::EpiDown E{(unsigned char*)(ws + WS_SLOT), (const LAS unsigned char*)cx.lds, (const LAS int*)(cx.lds + IDX_OFF), 1.0f / WGU_SCALE};
                pg8::gemm_phase<pg8::EpiDown, pg8::GroupedOrder, true, true>(cx.lds, g, S, E, cx.tid, nullptr);
            }
        }
        SEAM(base + 7);
        if (IN(base + 8)) {
            const bool poison = (l == DEPTH - 1) && (__hip_atomic_load(barw + XB_TMO, __ATOMIC_RELAXED, __HIP_MEMORY_SCOPE_AGENT) != 0u);
            for (int rep = 0; rep < REPS(11); ++rep) phase_combine(p, ldsb, l, poison);
        }
        if (l < DEPTH - 1) SEAM(base + 8);
    }
#undef IN
#undef SEAM
}

extern "C" void kernel_launch(void* const* d_in, const int* in_sizes, int n_in, void* d_out, int out_size, void* d_ws, size_t ws_size, hipStream_t stream) {
    static int grid = 0;
    if (grid == 0) {
        if (n_in != 19 || in_sizes[0] != NTOK * D || out_size != NTOK * D || ws_size < WS_END) {
            fprintf(stderr, "kernel_launch: unexpected shapes (n_in %d, in0 %d, out %d, ws %zu need %zu); nothing launched\n", n_in, n_in > 0 ? in_sizes[0] : -1, out_size, ws_size, (size_t)WS_END); grid = -1; return; }
        int dev = 0, cus = 0, per_cu = 0;
        if (hipGetDevice(&dev) != hipSuccess || hipDeviceGetAttribute(&cus, hipDeviceAttributeMultiprocessorCount, dev) != hipSuccess) { fprintf(stderr, "kernel_launch: device query failed\n"); grid = -1; return; }
        if (hipFuncSetAttribute((const void*)mk_fwd, hipFuncAttributeMaxDynamicSharedMemorySize, LDS_BYTES) != hipSuccess) { fprintf(stderr, "kernel_launch: hipFuncSetAttribute failed\n"); grid = -1; return; }
        if (hipOccupancyMaxActiveBlocksPerMultiprocessor(&per_cu, (const void*)mk_fwd, 512, LDS_BYTES) != hipSuccess || per_cu < 1)
            fprintf(stderr, "kernel_launch: note: occupancy query reports %d workgroups per CU\n", per_cu);
        (void)hipGetLastError();
        grid = cus;
    }
    if (grid < 0) return;
    if (hipMemsetAsync((char*)d_ws + WS_CTL, 0, CTL_ZERO_BYTES, stream) != hipSuccess) { fprintf(stderr, "kernel_launch: memset failed\n"); return; }
    Params p{};
    p.x = (const float*)d_in[0]; p.c = (const float*)d_in[1]; p.w_ada = (const float*)d_in[2]; p.b_ada = (const float*)d_in[3]; p.norm1_g = (const float*)d_in[4]; p.norm2_g = (const float*)d_in[5];
    p.w_in = (const float*)d_in[6]; p.conv_w = (const float*)d_in[7]; p.conv_norm_g = (const float*)d_in[8]; p.lower_bounds = (const float*)d_in[9]; p.hgrn_norm_g = (const float*)d_in[10];
    p.w_out = (const float*)d_in[11]; p.w_router = (const float*)d_in[12]; p.b_router = (const float*)d_in[13]; p.w_gu = (const float*)d_in[14]; p.b_gu = (const float*)d_in[15];
    p.w_down = (const float*)d_in[16]; p.b_down = (const float*)d_in[17]; p.final_g = (const float*)d_in[18];
    p.out = (float*)d_out; p.ws = (unsigned char*)d_ws;
#if MK_SPLIT
    for (int k = 0; k < NPH; ++k) { p.ph_lo = k; p.ph_hi = k + 1; hipLaunchKernelGGL(mk_fwd, dim3(grid), dim3(512), LDS_BYTES, stream, p); }
#else
    p.ph_lo = 0; p.ph_hi = NPH;
    hipLaunchKernelGGL(mk_fwd, dim3(grid), dim3(512), LDS_BYTES, stream, p);
#endif
    const hipError_t le = hipPeekAtLastError();
    if (le != hipSuccess) fprintf(stderr, "kernel_launch: launch failed: %s\n", hipGetErrorName(le));
}
```

```cpp
#include <hip/hip_runtime.h>
#include <cstdio>
#include <cstdint>

#ifndef MK_SPLIT
#define MK_SPLIT 0
#endif
#ifndef PROBE_REP
#define PROBE_REP 0
#endif
#define REPS(k) (1 + ((PROBE_REP >> (k)) & 1))

#define GAS __attribute__((address_space(1)))
#define LAS __attribute__((address_space(3)))
typedef unsigned short bf16_t;
typedef short bf16x8 __attribute__((ext_vector_type(8)));
typedef float f32x4 __attribute__((ext_vector_type(4)));
typedef float f32x2 __attribute__((ext_vector_type(2)));
typedef unsigned u32x4 __attribute__((ext_vector_type(4)));
typedef unsigned u32x2 __attribute__((ext_vector_type(2)));

constexpr int D = 1024, NBATCH = 2, SEQ = 16384, NTOK = NBATCH * SEQ, DEPTH = 4;
constexpr int NPROJ = 3584, NE = 32, TOPK = 4, NASSIGN = NTOK * TOPK;
constexpr int CHUNK = 64, NCHUNK = SEQ / CHUNK, NHEAD = 4, DK = 128;
constexpr int NUNIT = NBATCH * NHEAD * NCHUNK;
constexpr int MAXMBLK = NASSIGN / 256 + NE;
constexpr int PROWS = MAXMBLK * 256;
constexpr float RMS_EPS = 1e-6f;
constexpr float WGU_SCALE = 32.0f;
constexpr int NPO = 3072;
constexpr int PC_U = 0, PC_CB = 512, PC_Q = 1024, PC_F = 1536, PC_I = 2048, PC_OG = 2560;
__host__ __device__ constexpr int win_row(int n) { return n < 512 ? 1024 + n : n < 1024 ? 256 * ((n - 512) >> 7) + ((n - 512) & 127) : n < 1536 ? 256 * ((n - 1024) >> 7) + 128 + ((n - 1024) & 127) : n; }

constexpr size_t MiB = 1u << 20;
constexpr size_t WS_CTL = 0, CTL_ZERO_BYTES = 1 * MiB;
constexpr size_t WS_ADA = 1 * MiB;
constexpr size_t WS_LB = 1 * MiB + 512 * 1024;
constexpr size_t WS_RB = 1 * MiB + 768 * 1024;
constexpr size_t WS_WL = 1121 * MiB;
constexpr size_t WS_WIN = 2 * MiB;
constexpr size_t WS_WOUT = 30 * MiB;
constexpr size_t WS_WGU = 38 * MiB;
constexpr size_t WS_WDN = 550 * MiB;
constexpr size_t WS_HN = 806 * MiB;
constexpr size_t WS_PROJ = 872 * MiB;
constexpr size_t WS_U = 1096 * MiB;
constexpr size_t WS_CARRY = 1112 * MiB;
constexpr size_t WS_SEGD = 1120 * MiB;
constexpr size_t WS_DEC = 1224 * MiB;
constexpr size_t WS_ST8 = 1321 * MiB;
constexpr size_t WS_S = 1225 * MiB;
constexpr size_t WS_Y = 1289 * MiB;
constexpr size_t WS_X0 = 1353 * MiB;
constexpr size_t WS_X1 = 1481 * MiB;
constexpr size_t WS_LISTA = 1609 * MiB;
constexpr size_t WS_HN8 = 1720 * MiB;
constexpr size_t WS_ACT = 1881 * MiB;
constexpr size_t WS_SLOT = 2153 * MiB;
constexpr size_t WS_PADSLOT = 2409 * MiB;
constexpr size_t WS_PADGATE = 2410 * MiB;
constexpr size_t WS_TOKE = 2411 * MiB;
constexpr size_t WS_TOKPOS = 2411 * MiB + 512 * 1024;
constexpr size_t WS_TOKGATE = 2412 * MiB;
constexpr size_t WS_END = 2413 * MiB;
constexpr int CW_CNT = 1024;
constexpr int CW_BAR = 4096;
constexpr int CW_QUEUE = 8192;

constexpr int RING_BYTES = 131072;
constexpr int MISC_OFF = 139264;
constexpr int BIAS_OFF = 131072;
constexpr int IDX_OFF = 147456;
constexpr int MAXU = 32;
constexpr int LDS_BYTES = 163840;
constexpr int MS_BAR = 0;
constexpr int MS_PSTART = 64;
constexpr int MS_CNT = 256;
constexpr int MS_LCNT = 512;
constexpr int MS_GBASE = 768;
constexpr int MS_BLKE = 1024;
constexpr int MS_LE = 2048;
constexpr int MS_LPOS = 4096;
constexpr int MS_NM = 6144;

__device__ __forceinline__ unsigned pk2(float lo, float hi) { unsigned r; asm("v_cvt_pk_bf16_f32 %0, %1, %2" : "=v"(r) : "v"(lo), "v"(hi)); return r; }
__device__ __forceinline__ unsigned f2bf(float f) { return pk2(f, 0.f) & 0xffffu; }
__device__ __forceinline__ unsigned bf_rne(float f) { unsigned u = __float_as_uint(f); u += 0x7fffu + ((u >> 16) & 1u); return u >> 16; }
__device__ __forceinline__ float frcp(float x) { return __builtin_amdgcn_rcpf(x); }
__device__ __forceinline__ f32x2 v2exp2(f32x2 x) { return (f32x2){__builtin_amdgcn_exp2f(x.x), __builtin_amdgcn_exp2f(x.y)}; }
__device__ __forceinline__ f32x2 v2log2(f32x2 x) { return (f32x2){__builtin_amdgcn_logf(x.x), __builtin_amdgcn_logf(x.y)}; }
__device__ __forceinline__ f32x2 v2rcp(f32x2 x) { return (f32x2){__builtin_amdgcn_rcpf(x.x), __builtin_amdgcn_rcpf(x.y)}; }
__device__ __forceinline__ f32x2 v2bf(unsigned w) { return (f32x2){__uint_as_float(w << 16), __uint_as_float(w & 0xffff0000u)}; }
__device__ __forceinline__ unsigned pk2v(f32x2 v) { return pk2(v.x, v.y); }
constexpr float LOG2E = 1.4426950408889634f;
__device__ __forceinline__ float frsq(float x) { return __builtin_amdgcn_rsqf(x); }
__device__ __forceinline__ float bflo(unsigned w) { return __uint_as_float(w << 16); }
__device__ __forceinline__ float bfhi(unsigned w) { return __uint_as_float(w & 0xffff0000u); }
template <int CTRL> __device__ __forceinline__ float dpp_f(float v) { return __int_as_float(__builtin_amdgcn_update_dpp(0, __float_as_int(v), CTRL, 0xf, 0xf, false)); }
template <int CTRL> __device__ __forceinline__ int dpp_i(int v) { return __builtin_amdgcn_update_dpp(0, v, CTRL, 0xf, 0xf, false); }
__device__ __forceinline__ float row16_sum(float v) {
    v += dpp_f<0x128>(v); v += dpp_f<0x124>(v); v += dpp_f<0x122>(v); v += dpp_f<0x121>(v); return v; }
__device__ __forceinline__ float oct_sum(float v) {
    v += dpp_f<0xB1>(v); v += dpp_f<0x4E>(v); v += dpp_f<0x141>(v); return v; }
__device__ __forceinline__ float wave_sum(float v) { v = row16_sum(v); v += __shfl_xor(v, 16); v += __shfl_xor(v, 32); return v; }
__device__ __forceinline__ void unpack8(const u32x4 w, float (&o)[8]) { o[0] = bflo(w.x); o[1] = bfhi(w.x); o[2] = bflo(w.y); o[3] = bfhi(w.y); o[4] = bflo(w.z); o[5] = bfhi(w.z); o[6] = bflo(w.w); o[7] = bfhi(w.w); }
__device__ __forceinline__ u32x4 pack8(const float (&o)[8]) { u32x4 w; w.x = pk2(o[0], o[1]); w.y = pk2(o[2], o[3]); w.z = pk2(o[4], o[5]); w.w = pk2(o[6], o[7]); return w; }
__device__ __forceinline__ u32x2 pack8_fp8(const float (&o)[8]) { int lo = 0, hi = 0;
    lo = __builtin_amdgcn_cvt_pk_fp8_f32(o[0], o[1], lo, false); lo = __builtin_amdgcn_cvt_pk_fp8_f32(o[2], o[3], lo, true);
    hi = __builtin_amdgcn_cvt_pk_fp8_f32(o[4], o[5], hi, false); hi = __builtin_amdgcn_cvt_pk_fp8_f32(o[6], o[7], hi, true);
    return (u32x2){(unsigned)lo, (unsigned)hi}; }
__device__ __forceinline__ void unpack8_fp8(const u32x2 w, float (&o)[8]) {
    const f32x2 a = __builtin_amdgcn_cvt_pk_f32_fp8((int)w.x, false), b = __builtin_amdgcn_cvt_pk_f32_fp8((int)w.x, true);
    const f32x2 c = __builtin_amdgcn_cvt_pk_f32_fp8((int)w.y, false), d = __builtin_amdgcn_cvt_pk_f32_fp8((int)w.y, true);
    o[0] = a.x; o[1] = a.y; o[2] = b.x; o[3] = b.y; o[4] = c.x; o[5] = c.y; o[6] = d.x; o[7] = d.y; }
#define LDS_WAIT() asm volatile("s_waitcnt lgkmcnt(0)" ::: "memory")

namespace pg8 {
#define PG8_LAS __attribute__((address_space(3)))
constexpr int BM = 256, BK = 64, HALF = 128, HTB = HALF * BK * 2, STAGE_BYTES = 8 * HTB, NXCD = 8, WGM = 8;
__host__ __device__ __forceinline__ int lds_byte(int r, int c) { const int st = (r >> 4) * 2 + (c >> 5), rr = r & 15, cc = c & 31, ob = rr * 64 + cc * 2; return st * 1024 + (ob ^ (((ob >> 9) & 1) << 5)); }
__host__ __device__ __forceinline__ void stage_rc(int b, int& R, int& C) { const int st = b / 1024, sb = b % 1024, swz = sb ^ (((sb >> 9) & 1) << 5); R = (st >> 1) * 16 + swz / 64; C = (st & 1) * 32 + (swz % 64) / 2; }
__host__ __device__ __forceinline__ int perm32(int rho) { const int n = rho >> 4, i = rho & 15; return 8 * (i >> 2) + 4 * n + (i & 3); }

struct Unit { int pm, pn, e; };
struct Gemm { const bf16_t* A; const bf16_t* Bt; int M, N, K; size_t bgstride; };

struct StaticOrder {
    int nM, nN, nwg, G, c;
    __device__ void init(int nM_, int N, int G_, int c_) { nM = nM_; nN = N / BM; nwg = nM * nN; G = G_; c = c_; }
    __device__ bool next(int i, Unit& u) const {
        const long L = (long)i * G + c; if (L >= nwg) return false;
        int wgid = (int)L; { const int q = nwg / NXCD, r = nwg % NXCD, xcd = wgid % NXCD, off = wgid / NXCD; wgid = (xcd < r ? xcd * (q + 1) : r * (q + 1) + (xcd - r) * q) + off; }
        const int nig = WGM * nN, gid = wgid / nig, fm = gid * WGM, gsz = (nM - fm) < WGM ? (nM - fm) : WGM;
        u.pm = fm + ((wgid % nig) % gsz); u.pn = (wgid % nig) / gsz; u.e = 0; return true;
    }
};
struct GroupedOrder : StaticOrder {
    const PG8_LAS unsigned char* blk_e;
    __device__ bool next(int i, Unit& u) const { if (!StaticOrder::next(i, u)) return false; u.e = (int)blk_e[u.pm]; return true; }
};

__device__ __forceinline__ unsigned cvt_pk_bf16(float lo, float hi) { unsigned r; asm volatile("v_cvt_pk_bf16_f32 %0, %1, %2" : "=v"(r) : "v"(lo), "v"(hi)); return r; }

struct EpiProj {
    static constexpr bool PERM = true, WIDE = false;
    bf16_t* O;
    __device__ __forceinline__ void operator()(const f32x4 (&acc)[2][2][4][2], const Unit& u, int wr, int wc, int fr, int fq, int) const {
        const int row0 = u.pm * BM + wr * 64 + fr, c0 = wc * 32 + 8 * fq;
        if (u.pn < 4) {
#pragma unroll
            for (int ai = 0; ai < 2; ++ai)
#pragma unroll
                for (int m = 0; m < 4; ++m) { const f32x4 v0 = acc[ai][0][m][0] * acc[ai][1][m][0], v1 = acc[ai][0][m][1] * acc[ai][1][m][1];
                    u32x4 w; w.x = cvt_pk_bf16(v0[0], v0[1]); w.y = cvt_pk_bf16(v0[2], v0[3]); w.z = cvt_pk_bf16(v1[0], v1[1]); w.w = cvt_pk_bf16(v1[2], v1[3]);
                    *(u32x4*)(O + (size_t)(row0 + ai * HALF + m * 16) * NPO + 128 * u.pn + c0) = w; }
        } else {
            const int col0 = 512 + (u.pn - 4) * BM + c0;
#pragma unroll
            for (int ai = 0; ai < 2; ++ai)
#pragma unroll
                for (int m = 0; m < 4; ++m) { bf16_t* rowp = O + (size_t)(row0 + ai * HALF + m * 16) * NPO + col0;
#pragma unroll
                    for (int bj = 0; bj < 2; ++bj) { const f32x4 v0 = acc[ai][bj][m][0], v1 = acc[ai][bj][m][1];
                        u32x4 w; w.x = cvt_pk_bf16(v0[0], v0[1]); w.y = cvt_pk_bf16(v0[2], v0[3]); w.z = cvt_pk_bf16(v1[0], v1[1]); w.w = cvt_pk_bf16(v1[2], v1[3]);
                        *(u32x4*)(rowp + bj * HALF) = w; } }
        }
    }
};
struct EpiStoreBf16 {
    static constexpr bool PERM = true, WIDE = false;
    bf16_t* O; int ldc;
    __device__ __forceinline__ void operator()(const f32x4 (&acc)[2][2][4][2], const Unit& u, int wr, int wc, int fr, int fq, int) const {
        const int row0 = u.pm * BM + wr * 64 + fr, col0 = u.pn * BM + wc * 32 + 8 * fq;
#pragma unroll
        for (int ai = 0; ai < 2; ++ai)
#pragma unroll
            for (int m = 0; m < 4; ++m) { bf16_t* rowp = O + (size_t)(row0 + ai * HALF + m * 16) * ldc + col0;
#pragma unroll
                for (int bj = 0; bj < 2; ++bj) { const f32x4 v0 = acc[ai][bj][m][0], v1 = acc[ai][bj][m][1];
                    u32x4 w; w.x = cvt_pk_bf16(v0[0], v0[1]); w.y = cvt_pk_bf16(v0[2], v0[3]); w.z = cvt_pk_bf16(v1[0], v1[1]); w.w = cvt_pk_bf16(v1[2], v1[3]);
                    *(u32x4*)(rowp + bj * HALF) = w; } }
    }
};
template <bool IN_F32> struct EpiResidual {
    static constexpr bool PERM = true, WIDE = false;
    const void* xin; bf16_t* xout; const float* gvec; float wsc;
    __device__ __forceinline__ void operator()(const f32x4 (&acc)[2][2][4][2], const Unit& u, int wr, int wc, int fr, int fq, int) const {
        const int row0 = u.pm * BM + wr * 64 + fr, col0 = u.pn * BM + wc * 32 + 8 * fq;
        const float* gb = gvec + (size_t)((u.pm * BM) / SEQ) * (6 * D);
        f32x4 gv[2][2];
#pragma unroll
        for (int bj = 0; bj < 2; ++bj)
#pragma unroll
            for (int n = 0; n < 2; ++n) gv[bj][n] = *(const f32x4*)(gb + col0 + bj * HALF + 4 * n) * wsc;
#pragma unroll
        for (int ai = 0; ai < 2; ++ai)
#pragma unroll
            for (int m = 0; m < 4; ++m) { const size_t off = (size_t)(row0 + ai * HALF + m * 16) * D + col0;
                f32x4 x0[2], x1[2];
#pragma unroll
                for (int bj = 0; bj < 2; ++bj) {
                    if constexpr (IN_F32) { x0[bj] = *(const f32x4*)((const float*)xin + off + bj * HALF); x1[bj] = *(const f32x4*)((const float*)xin + off + bj * HALF + 4); }
                    else { const u32x4 w = *(const u32x4*)((const bf16_t*)xin + off + bj * HALF);
                        x0[bj] = (f32x4){__uint_as_float(w.x << 16), __uint_as_float(w.x & 0xffff0000u), __uint_as_float(w.y << 16), __uint_as_float(w.y & 0xffff0000u)};
                        x1[bj] = (f32x4){__uint_as_float(w.z << 16), __uint_as_float(w.z & 0xffff0000u), __uint_as_float(w.w << 16), __uint_as_float(w.w & 0xffff0000u)}; } }
#pragma unroll
                for (int bj = 0; bj < 2; ++bj) { const f32x4 v0 = x0[bj] + gv[bj][0] * acc[ai][bj][m][0], v1 = x1[bj] + gv[bj][1] * acc[ai][bj][m][1];
                    u32x4 w; w.x = cvt_pk_bf16(v0[0], v0[1]); w.y = cvt_pk_bf16(v0[2], v0[3]); w.z = cvt_pk_bf16(v1[0], v1[1]); w.w = cvt_pk_bf16(v1[2], v1[3]);
                    *(u32x4*)(xout + off + bj * HALF) = w; } }
    }
};
struct EpiGateUp {
    static constexpr bool PERM = true, WIDE = false;
    unsigned char* ACT; const PG8_LAS unsigned char* lds0; float wsc;
    __device__ __forceinline__ void operator()(const f32x4 (&acc)[2][2][4][2], const Unit& u, int wr, int wc, int fr, int fq, int ui) const {
        const int row0 = u.pm * BM + wr * 64 + fr, c0 = wc * 32 + 8 * fq, hc0 = u.pn * HALF + c0;
        f32x4 ba[2], bb[2];
        { const PG8_LAS unsigned char* bt = lds0 + (ui < 16 ? BIAS_OFF + ui * 512 : IDX_OFF + 17 * 512 + (ui - 16) * 512) + 2 * c0;
          const u32x4 wa = *(const PG8_LAS u32x4*)bt, wb = *(const PG8_LAS u32x4*)(bt + 256);
          ba[0] = (f32x4){__uint_as_float(wa.x << 16), __uint_as_float(wa.x & 0xffff0000u), __uint_as_float(wa.y << 16), __uint_as_float(wa.y & 0xffff0000u)};
          ba[1] = (f32x4){__uint_as_float(wa.z << 16), __uint_as_float(wa.z & 0xffff0000u), __uint_as_float(wa.w << 16), __uint_as_float(wa.w & 0xffff0000u)};
          bb[0] = (f32x4){__uint_as_float(wb.x << 16), __uint_as_float(wb.x & 0xffff0000u), __uint_as_float(wb.y << 16), __uint_as_float(wb.y & 0xffff0000u)};
          bb[1] = (f32x4){__uint_as_float(wb.z << 16), __uint_as_float(wb.z & 0xffff0000u), __uint_as_float(wb.w << 16), __uint_as_float(wb.w & 0xffff0000u)}; }
#pragma unroll
        for (int ai = 0; ai < 2; ++ai)
#pragma unroll
            for (int m = 0; m < 4; ++m) { float o[8];
#pragma unroll
                for (int n = 0; n < 2; ++n)
#pragma unroll
                    for (int h = 0; h < 2; ++h) {
                        f32x2 a = (f32x2){acc[ai][0][m][n][2 * h], acc[ai][0][m][n][2 * h + 1]} * wsc + (f32x2){ba[n][2 * h], ba[n][2 * h + 1]};
                        f32x2 b = (f32x2){acc[ai][1][m][n][2 * h], acc[ai][1][m][n][2 * h + 1]} * wsc + (f32x2){bb[n][2 * h], bb[n][2 * h + 1]};
                        a.x = fminf(a.x, 7.0f); a.y = fminf(a.y, 7.0f);
                        b.x = __builtin_amdgcn_fmed3f(b.x, -7.0f, 7.0f); b.y = __builtin_amdgcn_fmed3f(b.y, -7.0f, 7.0f);
                        const f32x2 t = a * -2.45546696f;
                        const f32x2 d = (f32x2){__builtin_amdgcn_exp2f(t.x), __builtin_amdgcn_exp2f(t.y)} + 1.0f;
                        const f32x2 r = (f32x2){__builtin_amdgcn_rcpf(d.x), __builtin_amdgcn_rcpf(d.y)};
                        const f32x2 res = (a * r) * (b + 1.0f);
                        o[4 * n + 2 * h] = res.x; o[4 * n + 2 * h + 1] = res.y; }
                *(u32x2*)(ACT + (size_t)(row0 + ai * HALF + m * 16) * D + hc0) = pack8_fp8(o); }
    }
};
struct EpiDown {
    static constexpr bool PERM = true, WIDE = true;
    unsigned char* SLOT; const PG8_LAS unsigned char* lds0;
    const PG8_LAS int* slot_tab;
    float wsc;
    __device__ __forceinline__ void operator()(const f32x4 (&acc)[2][2][4][2], const Unit& u, int wr, int wc, int fr, int fq, int ui) const {
        const int c0 = wc * 64 + 16 * fq, col0 = u.pn * BM + c0;
        const PG8_LAS int* st = slot_tab + ui * BM + wr * 64 + fr;
        f32x4 bv[2][2];
#pragma unroll
        for (int bj = 0; bj < 2; ++bj) { const u32x4 w = *(const PG8_LAS u32x4*)(lds0 + BIAS_OFF + ui * 512 + 2 * (c0 + 8 * bj));
            bv[bj][0] = (f32x4){__uint_as_float(w.x << 16), __uint_as_float(w.x & 0xffff0000u), __uint_as_float(w.y << 16), __uint_as_float(w.y & 0xffff0000u)};
            bv[bj][1] = (f32x4){__uint_as_float(w.z << 16), __uint_as_float(w.z & 0xffff0000u), __uint_as_float(w.w << 16), __uint_as_float(w.w & 0xffff0000u)}; }
#pragma unroll
        for (int ai = 0; ai < 2; ++ai)
#pragma unroll
            for (int m = 0; m < 4; ++m) { const int slot = st[ai * HALF + m * 16];
                if (slot >= 0) { u32x4 w4;
#pragma unroll
                    for (int bj = 0; bj < 2; ++bj) { const f32x4 v0 = acc[ai][bj][m][0] * wsc + bv[bj][0], v1 = acc[ai][bj][m][1] * wsc + bv[bj][1];
                        const float o[8] = {v0[0], v0[1], v0[2], v0[3], v1[0], v1[1], v1[2], v1[3]}; const u32x2 pk = pack8_fp8(o);
                        if (bj == 0) { w4.x = pk.x; w4.y = pk.y; } else { w4.z = pk.x; w4.w = pk.y; } }
                    *(u32x4*)(SLOT + (size_t)slot * D + col0) = w4; } }
    }
};

template <class Epi, class Sched, bool GATHER = false, bool FP8 = false, bool ALIGN_EPI = true>
__device__ __forceinline__ void gemm_phase(PG8_LAS unsigned char* lds, const Gemm g, const Sched& S, const Epi& E, const int tid, const PG8_LAS unsigned short* idx = nullptr) {
    const int wid = __builtin_amdgcn_readfirstlane(tid >> 6), lane = tid & 63, wr = wid >> 2, wc = wid & 3, fr = lane & 15, fq = lane >> 4;
    const int K = g.K, nt = K / BK;
    unsigned voffB[2]; int Ra[2], Ca[2];
#pragma unroll
    for (int i = 0; i < 2; ++i) { int R, C; stage_rc(tid * 16 + i * 8192, R, C);
        const int Rb = Epi::WIDE ? (64 * (R >> 5) + 16 * ((R & 15) >> 2) + 4 * ((R >> 4) & 1) + (R & 3)) : (Epi::PERM ? ((R & ~31) + perm32(R & 31)) : R);
        Ra[i] = R; Ca[i] = C; voffB[i] = (unsigned)(Rb * K + C) * 2u; }
    const size_t bhs = Epi::WIDE ? (size_t)8 * K * 2 : (size_t)HALF * K * 2;
    const size_t kstep = (size_t)(BK * 2);
    const size_t hstep = (size_t)HALF * K * 2;
    const size_t tstep = 2 * hstep;
    const unsigned ldsw = (unsigned)wid * 1024u;
    const int aoff = lds_byte(wr * 64 + fr, fq * 8), boff = lds_byte(wc * 32 + fr, fq * 8);
#define PG8_SA(b, h) (((b) * 2 + (h)) * HTB)
#define PG8_SB(b, h) ((4 + (b) * 2 + (h)) * HTB)
#define PG8_STAGE(bufoff, gbase, voff) do { _Pragma("unroll") for (int _i = 0; _i < 2; ++_i) \
        __builtin_amdgcn_global_load_lds((const unsigned*)((const char*)(gbase) + (voff)[_i]), (PG8_LAS unsigned*)(lds + (bufoff) + ldsw + _i * 8192), 16, 0, 0); } while (0)
#define PG8_LDA(dst, b, h) do { _Pragma("unroll") for (int m = 0; m < 4; ++m) _Pragma("unroll") for (int k = 0; k < 2; ++k) dst[m][k] = *(const PG8_LAS bf16x8*)(lds + PG8_SA(b, h) + aoff + m * 2048 + k * 1024); } while (0)
#define PG8_LDB(dst, b, h) do { _Pragma("unroll") for (int n = 0; n < 2; ++n) _Pragma("unroll") for (int k = 0; k < 2; ++k) dst[n][k] = *(const PG8_LAS bf16x8*)(lds + PG8_SB(b, h) + boff + n * 2048 + k * 1024); } while (0)
#define PG8_MMA(ai, bj, At, Bt) do { __builtin_amdgcn_s_setprio(1); _Pragma("unroll") for (int m = 0; m < 4; ++m) _Pragma("unroll") for (int n = 0; n < 2; ++n) { \
        if constexpr (FP8) { typedef int v4i_ __attribute__((ext_vector_type(4))); typedef int v8i_ __attribute__((ext_vector_type(8))); \
            const v8i_ wa = __builtin_shufflevector(__builtin_bit_cast(v4i_, Bt[n][0]), __builtin_bit_cast(v4i_, Bt[n][1]), 0, 1, 2, 3, 4, 5, 6, 7); \
            const v8i_ xa = __builtin_shufflevector(__builtin_bit_cast(v4i_, At[m][0]), __builtin_bit_cast(v4i_, At[m][1]), 0, 1, 2, 3, 4, 5, 6, 7); \
            acc[ai][bj][m][n] = __builtin_amdgcn_mfma_scale_f32_16x16x128_f8f6f4(wa, xa, acc[ai][bj][m][n], 0, 0, 0, 0x7f7f7f7f, 0, 0x7f7f7f7f); } \
        else { _Pragma("unroll") for (int k = 0; k < 2; ++k) acc[ai][bj][m][n] = __builtin_amdgcn_mfma_f32_16x16x32_bf16(Bt[n][k], At[m][k], acc[ai][bj][m][n], 0, 0, 0); } } \
        __builtin_amdgcn_s_setprio(0); } while (0)
#define PG8_WAIT_V(n) asm volatile("s_waitcnt vmcnt(" #n ")" ::: "memory")
#define PG8_WAIT_L(n) asm volatile("s_waitcnt lgkmcnt(" #n ")" ::: "memory")
#define PG8_BAR __builtin_amdgcn_s_barrier()
#define PG8_SCHED __builtin_amdgcn_sched_barrier(0)
#define PG8_AOFFS(dst, ui_, pm_) do { _Pragma("unroll") for (int _h = 0; _h < 2; ++_h) _Pragma("unroll") for (int _i = 0; _i < 2; ++_i) { \
        if constexpr (GATHER) dst[_h][_i] = (idx ? (unsigned)idx[(ui_) * BM + _h * HALF + Ra[_i]] : (unsigned)((pm_) * BM + _h * HALF + Ra[_i])) * (unsigned)(K * 2) + (unsigned)(Ca[_i] * 2); \
        else dst[_h][_i] = (unsigned)((_h * HALF + Ra[_i]) * K + Ca[_i]) * 2u; } } while (0)
    Unit cur, nxt; int ui = 0;
    if (!S.next(0, cur)) return;
    f32x4 acc[2][2][4][2];
#pragma unroll
    for (int a = 0; a < 2; ++a)
#pragma unroll
        for (int b = 0; b < 2; ++b)
#pragma unroll
            for (int m = 0; m < 4; ++m)
#pragma unroll
                for (int n = 0; n < 2; ++n) acc[a][b][m][n] = (f32x4){0.f, 0.f, 0.f, 0.f};
    bf16x8 At[4][2], B0[2][2], B1[2][2];
    unsigned offA[2][2];
    PG8_AOFFS(offA, 0, cur.pm);
    const char* cA = GATHER ? (const char*)g.A : (const char*)g.A + (size_t)cur.pm * tstep;
    const char* cB = (const char*)g.Bt + (size_t)cur.e * g.bgstride + (size_t)cur.pn * tstep;
    PG8_STAGE(PG8_SB(0, 0), cB, voffB); PG8_STAGE(PG8_SB(0, 1), cB + bhs, voffB); PG8_STAGE(PG8_SA(0, 0), cA, offA[0]); PG8_STAGE(PG8_SA(0, 1), cA, offA[1]);
    if (wr == 1) PG8_BAR;
    PG8_WAIT_V(2); PG8_BAR;
    PG8_STAGE(PG8_SB(1, 0), cB + kstep, voffB); PG8_STAGE(PG8_SA(1, 0), cA + kstep, offA[0]); PG8_STAGE(PG8_SB(1, 1), cB + bhs + kstep, voffB);
    PG8_WAIT_V(6); PG8_BAR;
    for (;;) {
        const bool has_next = S.next(ui + 1, nxt);
        const char* nA = GATHER ? (const char*)g.A : (has_next ? (const char*)g.A + (size_t)nxt.pm * tstep : cA);
        const char* nB = has_next ? (const char*)g.Bt + (size_t)nxt.e * g.bgstride + (size_t)nxt.pn * tstep : cB;
        for (int t = 0; t < nt; t += 2) {
            const bool last = (t == nt - 2);
            const char* a1 = cA + (size_t)(t + 1) * kstep;
            const char* a2 = last ? nA : cA + (size_t)(t + 2) * kstep; const char* b2 = last ? nB : cB + (size_t)(t + 2) * kstep;
            const char* a3 = a2 + kstep; const char* b3 = b2 + kstep;
            PG8_LDB(B0, 0, 0); PG8_LDB(B1, 0, 1); PG8_SCHED; PG8_LDA(At, 0, 0); PG8_STAGE(PG8_SA(1, 1), a1, offA[1]);
            if constexpr (GATHER) { if (last && has_next) PG8_AOFFS(offA, ui + 1, nxt.pm); }
            PG8_WAIT_V(8); PG8_WAIT_L(0); PG8_BAR; PG8_MMA(0, 0, At, B0); PG8_MMA(0, 1, At, B1); PG8_BAR; PG8_SCHED;
            PG8_LDA(At, 0, 1); PG8_STAGE(PG8_SB(0, 0), b2, voffB); PG8_STAGE(PG8_SB(0, 1), b2 + bhs, voffB); PG8_STAGE(PG8_SA(0, 0), a2, offA[0]);
            PG8_WAIT_V(8); PG8_WAIT_L(0); PG8_BAR; PG8_MMA(1, 0, At, B0); PG8_MMA(1, 1, At, B1); PG8_BAR; PG8_SCHED;
            PG8_LDB(B0, 1, 0); PG8_LDB(B1, 1, 1); PG8_SCHED; PG8_LDA(At, 1, 0); PG8_STAGE(PG8_SA(0, 1), a2, offA[1]);
            PG8_WAIT_V(8); PG8_WAIT_L(0); PG8_BAR; PG8_MMA(0, 0, At, B0); PG8_MMA(0, 1, At, B1); PG8_BAR; PG8_SCHED;
            PG8_LDA(At, 1, 1); PG8_STAGE(PG8_SB(1, 0), b3, voffB); PG8_STAGE(PG8_SB(1, 1), b3 + bhs, voffB); PG8_STAGE(PG8_SA(1, 0), a3, offA[0]);
            PG8_WAIT_V(8); PG8_WAIT_L(0); PG8_BAR; PG8_MMA(1, 0, At, B0); PG8_MMA(1, 1, At, B1); PG8_BAR; PG8_SCHED;
        }
        if constexpr (ALIGN_EPI) { if (wr == 0) PG8_BAR; }
        E(acc, cur, wr, wc, fr, fq, ui);
        if (!has_next) break;
#pragma unroll
        for (int a = 0; a < 2; ++a)
#pragma unroll
            for (int b = 0; b < 2; ++b)
#pragma unroll
                for (int m = 0; m < 4; ++m)
#pragma unroll
                    for (int n = 0; n < 2; ++n) acc[a][b][m][n] = (f32x4){0.f, 0.f, 0.f, 0.f};
        cur = nxt; cA = nA; cB = nB; ++ui;
        if constexpr (ALIGN_EPI) { if (wr == 1) PG8_BAR; }
    }
    PG8_WAIT_V(0);
    if constexpr (!ALIGN_EPI) { if (wr == 0) PG8_BAR; }
    PG8_BAR;
#undef PG8_SA
#undef PG8_SB
#undef PG8_STAGE
#undef PG8_LDA
#undef PG8_LDB
#undef PG8_MMA
#undef PG8_WAIT_V
#undef PG8_WAIT_L
#undef PG8_BAR
#undef PG8_SCHED
#undef PG8_AOFFS
}
}

#define XB_TMO      128
#define XB_XCNT(j)  (256  + 64 * (j))
#define XB_XSUB(j)  (1280 + 64 * (j))
#define XB_XGEN(j)  (2304 + 64 * (j))
#define XB_TOP      3328
#define XB_TOPGEN   3392
#define XCD_BAR_WORDS 3456
#define XB_SPIN_CAP (1u << 21)

__device__ __forceinline__ unsigned xb_ld(unsigned* p)              { return __hip_atomic_load(p, __ATOMIC_RELAXED, __HIP_MEMORY_SCOPE_AGENT); }
__device__ __forceinline__ unsigned xb_add(unsigned* p, unsigned v) { return __hip_atomic_fetch_add(p, v, __ATOMIC_RELAXED, __HIP_MEMORY_SCOPE_AGENT); }
__device__ __forceinline__ unsigned xb_xcc_id() { return (unsigned)__builtin_amdgcn_s_getreg((3 << 11) | 20) & 0xFu; }
#define XB_SPIN(cond, bar) do { unsigned _sp = 0; while (cond) { __builtin_amdgcn_s_sleep(1); \
    if ((++_sp & 255u) == 0u) { if (xb_ld(&(bar)[XB_TMO])) break; if (_sp > XB_SPIN_CAP) { atomicAdd(&(bar)[XB_TMO], 1u); break; } } } } while (0)

struct XcdBarrier { unsigned* bar; unsigned x; volatile LAS unsigned* st; };

__device__ __forceinline__ XcdBarrier xcd_barrier_post(unsigned* bar, volatile LAS unsigned* st) {
    XcdBarrier b; b.bar = bar; b.x = xb_xcc_id(); b.st = st;
    if (threadIdx.x == 0) (void)xb_add(&bar[XB_XCNT(b.x)], 1u);
    return b;
}
__device__ __forceinline__ void xcd_barrier_complete(unsigned* bar, unsigned x, unsigned& nloc, unsigned& nx) {
    const unsigned G = gridDim.x * gridDim.y * gridDim.z;
    unsigned sum, cnt, mine, sp = 0u;
    for (;;) {
        sum = 0u; cnt = 0u; mine = 0u;
#pragma unroll
        for (unsigned j = 0; j < 16; ++j) { const unsigned c = xb_ld(&bar[XB_XCNT(j)]); sum += c; cnt += (c > 0u) ? 1u : 0u; mine = (j == x) ? c : mine; }
        if (sum == G) break;
        __builtin_amdgcn_s_sleep(1);
        if ((++sp & 255u) == 0u) { if (xb_ld(&bar[XB_TMO])) break; if (sp > XB_SPIN_CAP) { atomicAdd(&bar[XB_TMO], 1u); break; } }
    }
    nloc = mine > 0u ? mine : 1u; nx = cnt > 0u ? cnt : 1u;
}
__device__ __forceinline__ void xcd_barrier(const XcdBarrier& b) {
    asm volatile("s_waitcnt vmcnt(0)" ::: "memory");
    __syncthreads();
    if (threadIdx.x == 0) {
        unsigned* bar = b.bar;
        __builtin_amdgcn_s_waitcnt(0);
        unsigned nloc = b.st[0], nx = b.st[1];
        if (nloc == 0u) { xcd_barrier_complete(bar, b.x, nloc, nx); b.st[0] = nloc; b.st[1] = nx; }
        const unsigned old = xb_add(&bar[XB_XSUB(b.x)], 1u);
        const unsigned gen = old / nloc;
        if (old + 1u == (gen + 1u) * nloc) {
            __builtin_amdgcn_fence(__ATOMIC_RELEASE, "agent");
            asm volatile("s_waitcnt vmcnt(0)" ::: "memory");
            const unsigned og = xb_add(&bar[XB_TOP], 1u);
            const unsigned tg = og / nx;
            if (og + 1u == (tg + 1u) * nx) xb_add(&bar[XB_TOPGEN], 1u);
            else XB_SPIN(xb_ld(&bar[XB_TOPGEN]) == tg, bar);
            __builtin_amdgcn_fence(__ATOMIC_ACQUIRE, "agent");
            xb_add(&bar[XB_XGEN(b.x)], 1u);
            asm volatile("s_waitcnt vmcnt(0)" ::: "memory");
        } else {
            XB_SPIN(xb_ld(&bar[XB_XGEN(b.x)]) == gen, bar);
            __builtin_amdgcn_fence(__ATOMIC_ACQUIRE, "agent");
            asm volatile("s_waitcnt vmcnt(0)" ::: "memory");
        }
    }
    __syncthreads();
}

struct Params {
    const float* x; const float* c; const float* w_ada; const float* b_ada; const float* norm1_g; const float* norm2_g; const float* w_in; const float* conv_w;
    const float* conv_norm_g; const float* lower_bounds; const float* hgrn_norm_g; const float* w_out; const float* w_router; const float* b_router;
    const float* w_gu; const float* b_gu; const float* w_down; const float* b_down; const float* final_g;
    float* out; unsigned char* ws;
    int ph_lo, ph_hi;
};

struct Ctx {
    LAS unsigned char* lds; int tid, lane, wave, G, gw, NGW, bid;
};
__device__ __forceinline__ Ctx make_ctx(LAS unsigned char* lds) {
    Ctx cx; int tid = threadIdx.x; asm volatile("" : "+v"(tid)); int bid = blockIdx.x; asm volatile("" : "+s"(bid)); int G = gridDim.x; asm volatile("" : "+s"(G));
    cx.lds = lds; cx.tid = tid; cx.lane = tid & 63; cx.wave = __builtin_amdgcn_readfirstlane(tid >> 6); cx.G = G; cx.gw = bid * 8 + cx.wave; cx.NGW = G * 8; cx.bid = bid;
    return cx;
}
__device__ __forceinline__ unsigned char* launder(unsigned char* q) { GAS unsigned char* g = (GAS unsigned char*)q; asm volatile("" : "+s"(g)); return (unsigned char*)g; }

__device__ __forceinline__ void transpose_item(const float* W, int N, bf16_t* WT, int k0, int n0, int wt_row0, LAS float* scr, int lane) {
    { float v[64];
#pragma unroll
      for (int i = 0; i < 64; ++i) v[i] = W[(size_t)(k0 + i) * N + n0 + lane];
#pragma unroll
      for (int i = 0; i < 64; ++i) scr[i * 65 + lane] = v[i]; }
    LDS_WAIT();
    const int c = lane & 7;
#pragma unroll
    for (int j = 0; j < 8; ++j) { const int n = (lane >> 3) + 8 * j; const LAS float* s = scr + (8 * c) * 65 + n;
        u32x4 o; o.x = pk2(s[0], s[65]); o.y = pk2(s[130], s[195]); o.z = pk2(s[260], s[325]); o.w = pk2(s[390], s[455]);
        *(u32x4*)(WT + (size_t)(wt_row0 + n) * D + k0 + 8 * c) = o; }
    LDS_WAIT();
}
__device__ __forceinline__ void transpose_item_fp8(const float* W, int N, unsigned char* WT, int k0, int n0, int wt_row0, float scale, LAS float* scr, int lane) {
    const int kq = lane >> 4, nq = lane & 15;
    f32x4 ld[16];
#pragma unroll
    for (int i = 0; i < 16; ++i) ld[i] = __builtin_nontemporal_load((const f32x4*)(W + (size_t)(k0 + 4 * i + kq) * N + n0 + 4 * nq));
#pragma unroll
    for (int i = 0; i < 16; ++i) *(LAS f32x4*)(scr + (4 * i + kq) * 68 + 4 * nq) = ld[i];
    LDS_WAIT();
    float v[64];
#pragma unroll
    for (int i = 0; i < 64; ++i) v[i] = scr[i * 68 + lane];
    LDS_WAIT();
    LAS unsigned char* sb = (LAS unsigned char*)scr;
#pragma unroll
    for (int q = 0; q < 4; ++q) { float o0[8], o1[8];
#pragma unroll
        for (int i = 0; i < 8; ++i) { o0[i] = v[16 * q + i] * scale; o1[i] = v[16 * q + 8 + i] * scale; }
        const u32x2 a = pack8_fp8(o0), c = pack8_fp8(o1);
        *(LAS u32x4*)(sb + lane * 80 + 16 * q) = (u32x4){a.x, a.y, c.x, c.y}; }
    LDS_WAIT();
#pragma unroll
    for (int i = 0; i < 4; ++i) { const int row = (lane >> 2) + 16 * i, pc = lane & 3;
        const u32x4 w = *(const LAS u32x4*)(sb + row * 80 + 16 * pc);
        *(u32x4*)(WT + (size_t)(wt_row0 + row) * D + k0 + 16 * pc) = w; }
    LDS_WAIT();
}
__device__ __forceinline__ void convert_item(const Params& p, unsigned char* ws, int l, int which, int it, LAS float* scr, int lane) {
    constexpr int I_GU = 16 * 32, I_DN = 16 * 16;
    if (which == 0) { const int mtx = l * NE + it / I_GU, q = it % I_GU, nb = q % 32, kb = q / 32; const int n0 = nb * 64;
        const int row0 = (n0 < 1024) ? (256 * (n0 >> 7) + (n0 & 127)) : (256 * ((n0 - 1024) >> 7) + 128 + ((n0 - 1024) & 127));
        transpose_item_fp8(p.w_gu + (size_t)mtx * D * 2048, 2048, (unsigned char*)(ws + WS_WGU) + (size_t)mtx * 2048 * D, kb * 64, n0, row0, WGU_SCALE, scr, lane);
    } else { const int mtx = l * NE + it / I_DN, q = it % I_DN, nb = q % 16, kb = q / 16;
        transpose_item_fp8(p.w_down + (size_t)mtx * D * D, D, (unsigned char*)(ws + WS_WDN) + (size_t)mtx * D * D, kb * 64, nb * 64, nb * 64, WGU_SCALE, scr, lane); }
}
constexpr int CONV_DELTA = 4;
constexpr int CONV_TOT_GU = NE * 16 * 32, CONV_TOT_DN = NE * 16 * 16;
constexpr int CONV_STAT_GU = CONV_TOT_GU * 3 / 4, CONV_STAT_DN = CONV_TOT_DN * 3 / 4;
__device__ __forceinline__ void convert_expert_weights(const Params& p, const Ctx& cx, unsigned char* ws, int l, int which, int r_hi = 0) {
    LAS float* scr = (LAS float*)(cx.lds + cx.wave * 17408);
    if (which == 0) {
        for (int it = cx.gw; it < CONV_STAT_GU; it += cx.NGW) convert_item(p, ws, l, 0, it, scr, cx.lane);
    } else {
        const int wlo = cx.G - r_hi; int rhi = (CONV_STAT_DN - CONV_DELTA * wlo * 8 + cx.NGW / 2) / cx.NGW; rhi = rhi < 0 ? 0 : rhi;
        for (int j = 0;; ++j) { int it;
            if (j < rhi) it = j * cx.NGW + cx.gw; else { if (cx.bid < r_hi) break; it = rhi * cx.NGW + (j - rhi) * wlo * 8 + (cx.bid - r_hi) * 8 + cx.wave; }
            if (it >= CONV_STAT_DN) break;
            convert_item(p, ws, l, 1, it, scr, cx.lane); }
    }
    __syncthreads();
}
__device__ __forceinline__ void convert_tail(const Params& p, const Ctx& cx, unsigned char* ws, int l, int which) {
    LAS float* scr = (LAS float*)(cx.lds + cx.wave * 17408);
    volatile LAS int* tick = (volatile LAS int*)(cx.lds + MISC_OFF + MS_BAR + 32);
    unsigned* q = (unsigned*)(ws + WS_CTL) + CW_QUEUE + 64 * (2 * l + which);
    const int first = which == 0 ? CONV_STAT_GU : CONV_STAT_DN, total = which == 0 ? CONV_TOT_GU : CONV_TOT_DN;
    if (cx.tid == 0) tick[0] = (int)__hip_atomic_fetch_add(q, 8u, __ATOMIC_RELAXED, __HIP_MEMORY_SCOPE_AGENT);
    __syncthreads();
    int t = tick[0], par = 0;
    while (first + t < total) {
        int nt = 0;
        if (cx.tid == 0) nt = (int)__hip_atomic_fetch_add(q, 8u, __ATOMIC_RELAXED, __HIP_MEMORY_SCOPE_AGENT);
        const int it = first + t + cx.wave;
        if (it < total) convert_item(p, ws, l, which, it, scr, cx.lane);
        par ^= 1;
        if (cx.tid == 0) tick[par] = nt;
        __syncthreads();
        t = tick[par];
    }
    __syncthreads();
}
__device__ __forceinline__ void phase_prologue(const Params& p, LAS unsigned char* ldsb) {
    const Ctx cx = make_ctx(ldsb);
    unsigned char* ws = launder(p.ws);
    LAS float* scr = (LAS float*)(cx.lds + cx.wave * 17408);
    constexpr int I_IN = 16 * (NPROJ / 64), I_OUT = 16 * 16;
    constexpr int T_IN = DEPTH * I_IN, T_OUT = DEPTH * I_OUT;
    for (int it = cx.gw; it < T_IN + T_OUT; it += cx.NGW) {
        int r = it;
        if (r < T_IN) { const int mtx = r / I_IN, q = r % I_IN, nb = q % (NPROJ / 64), kb = q / (NPROJ / 64);
            transpose_item(p.w_in + (size_t)mtx * D * NPROJ, NPROJ, (bf16_t*)(ws + WS_WIN) + (size_t)mtx * NPROJ * D, kb * 64, nb * 64, win_row(nb * 64), scr, cx.lane); continue; }
        r -= T_IN;
        { const int mtx = r / I_OUT, q = r % I_OUT, nb = q % 16, kb = q / 16;
            transpose_item_fp8(p.w_out + (size_t)mtx * D * D, D, (unsigned char*)(ws + WS_WOUT) + (size_t)mtx * D * D, kb * 64, nb * 64, nb * 64, WGU_SCALE, scr, cx.lane); }
    }
    __syncthreads();
    {
        LAS float* cact = (LAS float*)(cx.lds);
        LAS float* part = (LAS float*)(cx.lds + 8192);
        bool have = false;
        for (int item = cx.bid; item < DEPTH * 48; item += cx.G) {
            if (!have) { for (int i = cx.tid; i < 2 * D; i += 512) { const float v = p.c[i]; cact[i] = v / (1.0f + __expf(-v)); } have = true; __syncthreads(); }
            const int l = item / 48, col0 = (item % 48) * 128;
            const float* wp = p.w_ada + ((size_t)l * D + cx.wave * 128) * (6 * D) + col0 + 2 * cx.lane;
            float a00 = 0.f, a01 = 0.f, a10 = 0.f, a11 = 0.f;
#pragma unroll 8
            for (int kk = 0; kk < 128; ++kk) { const f32x2 wv = *(const f32x2*)(wp + (size_t)kk * (6 * D)); const float c0 = cact[cx.wave * 128 + kk], c1 = cact[D + cx.wave * 128 + kk];
                a00 += c0 * wv.x; a01 += c0 * wv.y; a10 += c1 * wv.x; a11 += c1 * wv.y; }
            part[(cx.wave * 2 + 0) * 128 + 2 * cx.lane] = a00; part[(cx.wave * 2 + 0) * 128 + 2 * cx.lane + 1] = a01;
            part[(cx.wave * 2 + 1) * 128 + 2 * cx.lane] = a10; part[(cx.wave * 2 + 1) * 128 + 2 * cx.lane + 1] = a11;
            __syncthreads();
            if (cx.tid < 256) { const int b = cx.tid >> 7, col = cx.tid & 127; float s = p.b_ada[(size_t)l * 6 * D + col0 + col];
#pragma unroll
                for (int w = 0; w < 8; ++w) s += part[(w * 2 + b) * 128 + col];
                ((float*)(ws + WS_ADA))[((size_t)l * 2 + b) * (6 * D) + col0 + col] = s; }
            __syncthreads();
        }
    }
    if (cx.bid == cx.G - 1) {
        const int ch = cx.tid;
        float v[DEPTH], m = -3.0e38f;
#pragma unroll
        for (int l = 0; l < DEPTH; ++l) { v[l] = p.lower_bounds[l * 512 + ch]; m = fmaxf(m, v[l]); }
        float s = 0.f;
#pragma unroll
        for (int l = 0; l < DEPTH; ++l) { v[l] = __expf(v[l] - m); s += v[l]; }
        float run = 0.f; float* LB = (float*)(ws + WS_LB);
        LB[ch] = 0.f;
#pragma unroll
        for (int l = 1; l < DEPTH; ++l) { run += v[l] / s; LB[l * 512 + ch] = run; }
    }
}

__device__ __forceinline__ void norm_mod_store(const f32x4 (&v)[4], const float* gnorm, const float* shift, const float* scale, bf16_t* orow, int lane) {
    float ss = 0.f;
#pragma unroll
    for (int j = 0; j < 4; ++j) ss += (v[j].x * v[j].x + v[j].y * v[j].y) + (v[j].z * v[j].z + v[j].w * v[j].w);
    const float rstd = frsq(wave_sum(ss) * (1.0f / D) + RMS_EPS);
#pragma unroll
    for (int j = 0; j < 4; ++j) { const int c = 4 * lane + 256 * j;
        const f32x4 g = *(const f32x4*)(gnorm + c), sh = *(const f32x4*)(shift + c), sc = *(const f32x4*)(scale + c);
        const f32x4 y = (v[j] * rstd) * g * (sc + 1.0f) + sh;
        u32x2 w; w.x = pk2(y.x, y.y); w.y = pk2(y.z, y.w);
        *(u32x2*)(orow + c) = w; }
}
__device__ __forceinline__ void norm_mod_store8(const float (&v)[2][8], const float* gnorm, const float* shift, const float* scale, bf16_t* orow, int lane) {
    float ss = 0.f;
#pragma unroll
    for (int j = 0; j < 2; ++j)
#pragma unroll
        for (int i = 0; i < 8; ++i) ss += v[j][i] * v[j][i];
    const float rstd = frsq(wave_sum(ss) * (1.0f / D) + RMS_EPS);
#pragma unroll
    for (int j = 0; j < 2; ++j) { const int c = 8 * lane + 512 * j; float o[8];
#pragma unroll
        for (int h = 0; h < 2; ++h) { const f32x4 g = *(const f32x4*)(gnorm + c + 4 * h), sh = *(const f32x4*)(shift + c + 4 * h), sc = *(const f32x4*)(scale + c + 4 * h);
#pragma unroll
            for (int i = 0; i < 4; ++i) o[4 * h + i] = (v[j][4 * h + i] * rstd) * g[i] * (sc[i] + 1.0f) + sh[i]; }
        *(u32x4*)(orow + c) = pack8(o); }
}
__device__ __forceinline__ void phase_norm1_first(const Params& p, LAS unsigned char* ldsb) {
    const Ctx cx = make_ctx(ldsb);
    unsigned char* ws = launder(p.ws);
    const float* ada = (const float*)(ws + WS_ADA);
    bf16_t* HN = (bf16_t*)(ws + WS_HN);
    for (int row = cx.gw; row < NTOK; row += cx.NGW) {
        const int b = row / SEQ; f32x4 v[4];
#pragma unroll
        for (int j = 0; j < 4; ++j) v[j] = __builtin_nontemporal_load((const f32x4*)(p.x + (size_t)row * D + 4 * cx.lane + 256 * j));
        norm_mod_store(v, p.norm1_g, ada + (size_t)b * 6 * D + 0 * D, ada + (size_t)b * 6 * D + 1 * D, HN + (size_t)row * D, cx.lane);
    }
    if (cx.bid == cx.G - 1 && cx.tid < 64) ((u32x4*)(ws + WS_HN8 + (size_t)NTOK * D))[cx.tid] = (u32x4){0u, 0u, 0u, 0u};
    { u32x4* WLG = (u32x4*)(ws + WS_WL);
      for (int idx = cx.bid * 512 + cx.tid; idx < DEPTH * 2 * 4096; idx += cx.G * 512) { const int lb2 = idx >> 12, f = idx & 4095, l = lb2 >> 1, b = lb2 & 1;
          const int sk = f >> 7, nt = (f >> 6) & 1, ln = f & 63, gg = ln >> 4, c = ln & 15, k0 = 32 * sk + 8 * gg, e = 16 * nt + c;
          const float* sc = ada + ((size_t)l * 2 + b) * 6 * D + 4 * D; const float* gn = p.norm2_g + (size_t)l * D; const float* wr_l = p.w_router + (size_t)l * D * NE;
          float hi[8], lo[8];
#pragma unroll
          for (int i = 0; i < 8; ++i) { const float w = gn[k0 + i] * (1.0f + sc[k0 + i]) * wr_l[(size_t)(k0 + i) * NE + e]; const float h = __uint_as_float(f2bf(w) << 16); hi[i] = h; lo[i] = w - h; }
          u32x4* dst = WLG + (size_t)lb2 * 8192 + (size_t)((sk * 2 + nt) * 2) * 64 + ln;
          dst[0] = pack8(hi); dst[64] = pack8(lo); } }
    for (int item = cx.bid; item < DEPTH * 2; item += cx.G) {
        const int l = item >> 1, b = item & 1; LAS float* part = (LAS float*)cx.lds;
        const float* sh = ada + ((size_t)l * 2 + b) * 6 * D + 3 * D; const float* wr_l = p.w_router + (size_t)l * D * NE;
        const int e = cx.tid & 31, pt = cx.tid >> 5; float s = 0.f;
        for (int k = pt * 64; k < pt * 64 + 64; ++k) s += sh[k] * wr_l[(size_t)k * NE + e];
        __syncthreads(); part[pt * 32 + e] = s; __syncthreads();
        if (cx.tid < NE) { float t = p.b_router[(size_t)l * NE + cx.tid];
#pragma unroll
            for (int q = 0; q < 16; ++q) t += part[q * 32 + cx.tid];
            ((float*)(ws + WS_RB))[((size_t)l * 2 + b) * NE + cx.tid] = t; }
    }
}

__device__ __forceinline__ void hgrn_gates(const unsigned (&fw)[8]  , const f32x2 lb, LAS float* tot, int e, int lane,
                                           f32x2 (&G)[8], f32x2 (&kf)[8], f32x2 (&pre)[9]) {
    f32x2 run = (f32x2){0.f, 0.f}; const f32x2 oml = 1.0f - lb;
#pragma unroll
    for (int j = 0; j < 8; ++j) { f32x2 f = v2bf(fw[j]); f.x = fmaxf(f.x, -60.f); f.y = fmaxf(f.y, -60.f);
        const f32x2 en = v2exp2(f * (-LOG2E)), sg = v2rcp((f32x2){en.x + 1.0f, en.y + 1.0f});
        run += v2log2(lb + oml * sg);
        kf[j] = oml * en * sg;
        G[j] = run; }
    *(LAS f32x2*)(tot + e * 128 + 2 * lane) = run;
    __syncthreads();
    pre[0] = (f32x2){0.f, 0.f};
#pragma unroll
    for (int k = 0; k < 8; ++k) pre[k + 1] = pre[k] + *(const LAS f32x2*)(tot + k * 128 + 2 * lane);
    f32x2 off = (f32x2){0.f, 0.f};
#pragma unroll
    for (int k = 0; k < 8; ++k) if (k == e) off = pre[k];
#pragma unroll
    for (int j = 0; j < 8; ++j) G[j] += off;
}
__device__ __forceinline__ void load_words8(unsigned (&w)[8], const bf16_t* ubase  , unsigned voff  ) {
#pragma unroll
    for (int j = 0; j < 8; ++j) w[j] = *(const unsigned*)((const char*)(ubase + (size_t)j * NPO) + voff);
}
__device__ __forceinline__ void pack_t8(const unsigned (&w)[8], u32x4& lo, u32x4& hi) {
    lo.x = (w[0] & 0xffffu) | (w[1] << 16); lo.y = (w[2] & 0xffffu) | (w[3] << 16); lo.z = (w[4] & 0xffffu) | (w[5] << 16); lo.w = (w[6] & 0xffffu) | (w[7] << 16);
    hi.x = (w[0] >> 16) | (w[1] & 0xffff0000u); hi.y = (w[2] >> 16) | (w[3] & 0xffff0000u); hi.z = (w[4] >> 16) | (w[5] & 0xffff0000u); hi.w = (w[6] >> 16) | (w[7] & 0xffff0000u);
}
#define MFMA16(a, b, c) __builtin_amdgcn_mfma_f32_16x16x32_bf16((a), (b), (c), 0, 0, 0)

constexpr float ST8_SCALE = 4.0f;
__device__ __forceinline__ void phase_hgrn_local(const Params& p, LAS unsigned char* ldsb, int l) {
    const Ctx cx = make_ctx(ldsb);
    unsigned char* ws = launder(p.ws);
    const bf16_t* PROJ = (const bf16_t*)(ws + WS_PROJ);
    const float* LB = (const float*)(ws + WS_LB) + l * 512;
    bf16_t* SEGS = (bf16_t*)(ws + WS_U); float* SEGD = (float*)(ws + WS_SEGD); float* DEC = (float*)(ws + WS_DEC); unsigned char* ST = (unsigned char*)(ws + WS_S);
    constexpr int KH_OFF = 0, VT_OFF = 18432, TOT_OFF = 36864, DN_OFF = 40960, RS = 144;
    LAS unsigned char* lds = cx.lds; LAS float* tot = (LAS float*)(lds + TOT_OFF); LAS float* dnl = (LAS float*)(lds + DN_OFF);
    const int e = cx.wave, lane = cx.lane, r = lane & 15, g = lane >> 4;
    constexpr int SL_OFF = 45056, SLS = 144;
#define HL_STORE_TILE(uid_) do { unsigned char* sb_ = ST + (size_t)(uid_) * (DK * DK) + 1024 * e; const unsigned lo_ = 16u * (unsigned)lane; _Pragma("unroll") for (int h2 = 0; h2 < 2; ++h2) \
        *(u32x4*)(sb_ + 8192 * h2 + lo_) = *(const LAS u32x4*)(lds + SL_OFF + 1152 * e + 64 * SLS * h2 + lo_ + 16u * ((unsigned)lane >> 3)); } while (0)
    for (int seg = cx.bid; seg < NUNIT / 8; seg += cx.G) {
        const int bh = seg >> 5, b = bh >> 2, h = bh & 3;
        const f32x2 lb = *(const f32x2*)(LB + 128 * h + 2 * lane);
        const int mb = e >> 1, nb = e & 1;
        f32x4 acc[2][4];
#pragma unroll
        for (int mi = 0; mi < 2; ++mi)
#pragma unroll
            for (int ni = 0; ni < 4; ++ni) acc[mi][ni] = (f32x4){0.f, 0.f, 0.f, 0.f};
        f32x2 cum = (f32x2){0.f, 0.f};
        asm volatile("" : "+v"(cum));
        const bf16_t* base0 = PROJ + ((size_t)b * SEQ + (size_t)(seg & 31) * 8 * CHUNK + 8 * e) * NPO + 128 * h;
        const unsigned lvo = 4u * (unsigned)lane;
        unsigned fw[8], vw[8];
        load_words8(fw, base0 + PC_F, lvo); load_words8(vw, base0 + PC_I, lvo);
        for (int j = 0; j < 8; ++j) {
            const int uid = seg * 8 + j;
            f32x2 G[8], kf[8], pre[9];
            hgrn_gates(fw, lb, tot, e, lane, G, kf, pre);
            if (j > 0) HL_STORE_TILE(uid - 1);
            { unsigned w[8];
#pragma unroll
              for (int q = 0; q < 8; ++q) w[q] = pk2v(kf[q] * v2exp2(pre[8] - G[q]));
              u32x4 lo, hi; pack_t8(w, lo, hi);
              *(LAS u32x4*)(lds + KH_OFF + (2 * lane) * RS + 16 * e) = lo; *(LAS u32x4*)(lds + KH_OFF + (2 * lane + 1) * RS + 16 * e) = hi; }
            { u32x4 lo, hi; pack_t8(vw, lo, hi);
              *(LAS u32x4*)(lds + VT_OFF + (2 * lane) * RS + 16 * e) = lo; *(LAS u32x4*)(lds + VT_OFF + (2 * lane + 1) * RS + 16 * e) = hi; }
            if (e == 0) { *(f32x2*)(DEC + (size_t)uid * DK + 2 * lane) = v2exp2(cum);
                          *(LAS f32x2*)(dnl + 2 * lane) = v2exp2(pre[8]); }
            cum += pre[8];
            if (j < 7) { const bf16_t* bn = base0 + (size_t)(j + 1) * CHUNK * NPO; load_words8(fw, bn + PC_F, lvo); load_words8(vw, bn + PC_I, lvo); }
            __syncthreads();
            {
#pragma unroll
              for (int mi = 0; mi < 2; ++mi) { const f32x4 dn = *(const LAS f32x4*)(dnl + 32 * mb + 16 * mi + 4 * g);
#pragma unroll
                  for (int ni = 0; ni < 4; ++ni) { const f32x4 a = acc[mi][ni]; const f32x4 a4 = a * ST8_SCALE;
                      int w = __builtin_amdgcn_cvt_pk_fp8_f32(a4.x, a4.y, 0, false); w = __builtin_amdgcn_cvt_pk_fp8_f32(a4.z, a4.w, w, true);
                      *(LAS int*)(lds + SL_OFF + (64 * nb + 16 * ni + r) * SLS + 32 * mb + 16 * mi + 4 * g) = w;
                      acc[mi][ni] = a * dn; } } }
#pragma unroll
            for (int ks = 0; ks < 2; ++ks) {
                bf16x8 a[2], bb[4];
#pragma unroll
                for (int mi = 0; mi < 2; ++mi) a[mi] = *(const LAS bf16x8*)(lds + KH_OFF + (32 * mb + 16 * mi + r) * RS + (32 * ks + 8 * g) * 2);
#pragma unroll
                for (int ni = 0; ni < 4; ++ni) bb[ni] = *(const LAS bf16x8*)(lds + VT_OFF + (64 * nb + 16 * ni + r) * RS + (32 * ks + 8 * g) * 2);
#pragma unroll
                for (int mi = 0; mi < 2; ++mi)
#pragma unroll
                    for (int ni = 0; ni < 4; ++ni) acc[mi][ni] = MFMA16(a[mi], bb[ni], acc[mi][ni]);
            }
        }
        __syncthreads();
        HL_STORE_TILE(seg * 8 + 7);
        { bf16_t* ub = SEGS + (size_t)seg * (DK * DK);
#pragma unroll
          for (int mi = 0; mi < 2; ++mi)
#pragma unroll
              for (int ni = 0; ni < 4; ++ni) { const f32x4 a = acc[mi][ni]; u32x2 w;
                  w.x = bf_rne(a.x) | (bf_rne(a.y) << 16); w.y = bf_rne(a.z) | (bf_rne(a.w) << 16);
                  *(u32x2*)(ub + (size_t)(64 * nb + 16 * ni + r) * DK + 32 * mb + 16 * mi + 4 * g) = w; }
          if (e == 0) *(f32x2*)(SEGD + (size_t)seg * DK + 2 * lane) = v2exp2(cum); }
    }
#undef HL_STORE_TILE
    {
        unsigned char* Y = (unsigned char*)(ws + WS_Y);
        const float* cw = p.conv_w + (size_t)l * 3 * 512 + 8 * lane; const float* cg = p.conv_norm_g + (size_t)l * 512 + 8 * lane;
        float w0[8], w1[8], w2[8], gn[8];
#pragma unroll
        for (int i = 0; i < 8; ++i) { w0[i] = cw[i]; w1[i] = cw[512 + i]; w2[i] = cw[1024 + i]; gn[i] = cg[i]; }
        for (int run = cx.gw; run < NTOK / 8; run += cx.NGW) {
            const int t0 = run * 8; const bool first = (t0 & (SEQ - 1)) == 0;
            u32x4 uw[10], cb[8];
#pragma unroll
            for (int i = 0; i < 10; ++i) { const size_t t = (size_t)(first && i < 2 ? t0 : t0 - 2 + i);
                uw[i] = __builtin_nontemporal_load((const u32x4*)(PROJ + t * NPO + PC_U + 8 * lane)); }
#pragma unroll
            for (int i = 0; i < 8; ++i) cb[i] = __builtin_nontemporal_load((const u32x4*)(PROJ + (size_t)(t0 + i) * NPO + PC_CB + 8 * lane));
            float um2[8], um1[8];
#pragma unroll
            for (int q = 0; q < 4; ++q) { um2[2 * q] = first ? 0.f : bflo(uw[0][q]); um2[2 * q + 1] = first ? 0.f : bfhi(uw[0][q]);
                um1[2 * q] = first ? 0.f : bflo(uw[1][q]); um1[2 * q + 1] = first ? 0.f : bfhi(uw[1][q]); }
#pragma unroll
            for (int i = 0; i < 8; ++i) { const size_t t = (size_t)(t0 + i);
                float u[8], y[8], ss = 0.f;
#pragma unroll
                for (int q = 0; q < 4; ++q) { u[2 * q] = bflo(uw[i + 2][q]); u[2 * q + 1] = bfhi(uw[i + 2][q]); }
#pragma unroll
                for (int q = 0; q < 4; ++q) { y[2 * q] = bflo(cb[i][q]) * (w0[2 * q] * um2[2 * q] + w1[2 * q] * um1[2 * q] + w2[2 * q] * u[2 * q]);
                    y[2 * q + 1] = bfhi(cb[i][q]) * (w0[2 * q + 1] * um2[2 * q + 1] + w1[2 * q + 1] * um1[2 * q + 1] + w2[2 * q + 1] * u[2 * q + 1]); }
#pragma unroll
                for (int q = 0; q < 8; ++q) ss += y[q] * y[q];
                ss = oct_sum(ss);
                const float rstd = frsq(ss * (1.0f / 64.0f) + RMS_EPS);
                float o8[8];
#pragma unroll
                for (int q = 0; q < 8; ++q) o8[q] = y[q] * rstd * gn[q];
                *(u32x2*)(Y + t * D + 8 * lane) = pack8_fp8(o8);
#pragma unroll
                for (int q = 0; q < 8; ++q) { um2[q] = um1[q]; um1[q] = u[q]; }
            }
        }
    }
}

__device__ __forceinline__ void phase_hgrn_scan(const Params& p, LAS unsigned char* ldsb) {
    const Ctx cx = make_ctx(ldsb);
    unsigned char* ws = launder(p.ws);
    const bf16_t* SEGS = (const bf16_t*)(ws + WS_U); const float* SEGD = (const float*)(ws + WS_SEGD); const float* DEC = (const float*)(ws + WS_DEC); const unsigned char* ST = (const unsigned char*)(ws + WS_S); unsigned char* ST8 = (unsigned char*)(ws + WS_ST8);
    constexpr int NQ = NBATCH * NHEAD * DK * DK / 4, SCAN_T = 128;
    if (cx.tid >= SCAN_T) return;
    for (int q4 = cx.bid * SCAN_T + cx.tid; q4 < NQ; q4 += cx.G * SCAN_T) {
        const int eidx = 4 * q4, bh = eidx >> 14, rem = eidx & 16383, dk = rem & 127;
        const bf16_t* up = SEGS + (size_t)bh * 32 * (DK * DK) + rem; const float* dp = SEGD + (size_t)bh * 32 * DK + dk;
        const unsigned char* sp = ST + (size_t)bh * NCHUNK * (DK * DK) + rem; unsigned char* sq = ST8 + (size_t)bh * NCHUNK * (DK * DK) + rem; const float* pp = DEC + (size_t)bh * NCHUNK * DK + dk;
        f32x4 S = (f32x4){0.f, 0.f, 0.f, 0.f};
        for (int sg = 0; sg < 32; sg += 2) {
            u32x2 uw[2]; f32x4 d[2], pn[16]; unsigned sv[16];
#pragma unroll
            for (int i = 0; i < 2; ++i) { uw[i] = *(const u32x2*)(up + (size_t)(sg + i) * (DK * DK)); d[i] = *(const f32x4*)(dp + (size_t)(sg + i) * DK); }
#pragma unroll
            for (int i = 0; i < 16; ++i) { sv[i] = *(const unsigned*)(sp + (size_t)(sg * 8 + i) * (DK * DK)); pn[i] = *(const f32x4*)(pp + (size_t)(sg * 8 + i) * DK); }
#pragma unroll
            for (int i = 0; i < 2; ++i) {
#pragma unroll
                for (int j = 0; j < 8; ++j) { const int w = (int)sv[i * 8 + j];
                    const f32x2 lo = __builtin_amdgcn_cvt_pk_f32_fp8(w, false), hi = __builtin_amdgcn_cvt_pk_f32_fp8(w, true);
                    const f32x4 v = (f32x4){lo.x, lo.y, hi.x, hi.y} + pn[i * 8 + j] * S * ST8_SCALE;
                    int o = __builtin_amdgcn_cvt_pk_fp8_f32(v.x, v.y, 0, false); o = __builtin_amdgcn_cvt_pk_fp8_f32(v.z, v.w, o, true);
                    *(int*)(sq + (size_t)((sg + i) * 8 + j) * (DK * DK)) = o; }
                const f32x4 u = (f32x4){bflo(uw[i].x), bfhi(uw[i].x), bflo(uw[i].y), bfhi(uw[i].y)};
                S = d[i] * S + u; }
        }
    }
}

__device__ __forceinline__ void phase_hgrn_out(const Params& p, LAS unsigned char* ldsb, int l) {
    const Ctx cx = make_ctx(ldsb);
    unsigned char* ws = launder(p.ws);
    const bf16_t* PROJ = (const bf16_t*)(ws + WS_PROJ); const unsigned char* ST8 = (const unsigned char*)(ws + WS_ST8); unsigned char* Y = (unsigned char*)(ws + WS_Y);
    const float* LB = (const float*)(ws + WS_LB) + l * 512;
    constexpr int QH_OFF = 0, QT_OFF = 17408, KT_OFF = 34816, VT_OFF = 78336, P_OFF = 96768, TOT_OFF = 105984, QP_OFF = 110080, RQ = 272, RS = 144, OL_OFF = KT_OFF, OLS = 132;
    LAS unsigned char* lds = cx.lds; LAS float* tot = (LAS float*)(lds + TOT_OFF);
    const int e = cx.wave, lane = cx.lane, r = lane & 15, g = lane >> 4;
    for (int seg = cx.bid; seg < NUNIT / 8; seg += cx.G) {
        const int bh = seg >> 5, b = bh >> 2, h = bh & 3;
        const f32x2 lb = *(const f32x2*)(LB + 128 * h + 2 * lane);
        const f32x2 gnv = *(const f32x2*)(p.hgrn_norm_g + (size_t)l * 512 + 128 * h + 2 * lane);
        const bf16_t* base0 = PROJ + ((size_t)b * SEQ + (size_t)(seg & 31) * 8 * CHUNK + 8 * e) * NPO + 128 * h;
        const unsigned lvo = 4u * (unsigned)lane;
        unsigned fw[8], qw[8], vw[8];
        load_words8(fw, base0 + PC_F, lvo); load_words8(qw, base0 + PC_Q, lvo); load_words8(vw, base0 + PC_I, lvo);
        const int it = e & 3, nb = e >> 2; f32x4 acc[4];
        for (int jc = 0; jc < 8; ++jc) {
        const int uid = seg * 8 + jc;
        const size_t row0 = (size_t)b * SEQ + (size_t)((seg & 31) * 8 + jc) * CHUNK;
        u32x4 sraw[4][2];
        { const unsigned char* sb = ST8 + (size_t)uid * (DK * DK);
#pragma unroll
          for (int ni = 0; ni < 4; ++ni)
#pragma unroll
              for (int hh = 0; hh < 2; ++hh) sraw[ni][hh] = *(const u32x4*)(sb + (size_t)(64 * nb + 16 * ni + r) * DK + 32 * g + 16 * hh); }
        f32x2 G[8], kf[8], pre[9];
        hgrn_gates(fw, lb, tot, e, lane, G, kf, pre);
        const int isub = e >> 1;
        f32x2 R[4];
#pragma unroll
        for (int i = 0; i < 4; ++i) R[i] = pre[2 * i];
        f32x2 Ri = (f32x2){0.f, 0.f};
#pragma unroll
        for (int i = 0; i < 4; ++i) if (i == isub) Ri = R[i];
        { const f32x2 eR = v2exp2(Ri);
#pragma unroll
          for (int j = 0; j < 8; ++j) { const f32x2 q = v2bf(qw[j]); const int t = 8 * e + j;
            const f32x2 sq = q * v2rcp(v2exp2(q * (-LOG2E)) + 1.0f);
            const f32x2 tq = sq * v2exp2(G[j] - Ri);
            *(LAS unsigned*)(lds + QT_OFF + t * RQ + 4 * lane) = pk2v(tq);
            *(LAS unsigned*)(lds + QH_OFF + t * RQ + 4 * lane) = pk2v(tq * eR); } }
        { f32x2 kd[8];
#pragma unroll
          for (int j = 0; j < 8; ++j) { f32x2 x = Ri - G[j]; x.x = fminf(x.x, 115.f); x.y = fminf(x.y, 115.f); kd[j] = kf[j] * v2exp2(x); }
#pragma unroll
          for (int i = 0; i < 4; ++i) if (i >= isub) { const f32x2 fc = v2exp2(R[i] - Ri);
#pragma unroll
              for (int j = 0; j < 8; ++j) { const int t = 8 * e + j;
                  *(LAS unsigned*)(lds + KT_OFF + (8 * i * (i + 1) + t) * RQ + 4 * lane) = pk2v(kd[j] * fc); } } }
        { u32x4 lo, hi; pack_t8(vw, lo, hi);
          *(LAS u32x4*)(lds + VT_OFF + (2 * lane) * RS + 16 * e) = lo; *(LAS u32x4*)(lds + VT_OFF + (2 * lane + 1) * RS + 16 * e) = hi; }
        if (jc < 7) { const bf16_t* bn = base0 + (size_t)(jc + 1) * CHUNK * NPO; load_words8(fw, bn + PC_F, lvo); load_words8(qw, bn + PC_Q, lvo); load_words8(vw, bn + PC_I, lvo); }
        unsigned ogw[8];
        load_words8(ogw, base0 + (size_t)jc * CHUNK * NPO + PC_OG, lvo);
        __syncthreads();
        { const int i = e >> 1;
#pragma unroll
          for (int jx = 0; jx < 2; ++jx) { const int j = 2 * (e & 1) + jx; f32x4 acc = (f32x4){0.f, 0.f, 0.f, 0.f};
              if (j <= i) {
#pragma unroll
                  for (int ks = 0; ks < 4; ++ks) { const bf16x8 a = *(const LAS bf16x8*)(lds + QT_OFF + (16 * i + r) * RQ + (32 * ks + 8 * g) * 2);
                      const bf16x8 bb = *(const LAS bf16x8*)(lds + KT_OFF + (8 * i * (i + 1) + 16 * j + r) * RQ + (32 * ks + 8 * g) * 2);
                      acc = MFMA16(a, bb, acc); } }
#pragma unroll
              for (int reg = 0; reg < 4; ++reg) { const int tl = 4 * g + reg; const float v = (j < i || (j == i && r <= tl)) ? acc[reg] : 0.f;
                  *(LAS bf16_t*)(lds + P_OFF + (16 * i + tl) * RS + (16 * j + r) * 2) = (bf16_t)f2bf(v); } } }
#pragma unroll
        for (int ni = 0; ni < 4; ++ni) acc[ni] = (f32x4){0.f, 0.f, 0.f, 0.f};
#pragma unroll
        for (int ks = 0; ks < 4; ++ks) { const bf16x8 a = *(const LAS bf16x8*)(lds + QH_OFF + (16 * it + r) * RQ + (32 * g + 8 * ks) * 2);
#pragma unroll
            for (int ni = 0; ni < 4; ++ni) { const u32x4 q4 = sraw[ni][ks >> 1]; const int w0 = (ks & 1) ? (int)q4.z : (int)q4.x, w1 = (ks & 1) ? (int)q4.w : (int)q4.y;
                u32x4 fb;
                fb.x = __builtin_bit_cast(unsigned, __builtin_amdgcn_cvt_scalef32_pk_bf16_fp8(w0, 1.0f / ST8_SCALE, false)); fb.y = __builtin_bit_cast(unsigned, __builtin_amdgcn_cvt_scalef32_pk_bf16_fp8(w0, 1.0f / ST8_SCALE, true));
                fb.z = __builtin_bit_cast(unsigned, __builtin_amdgcn_cvt_scalef32_pk_bf16_fp8(w1, 1.0f / ST8_SCALE, false)); fb.w = __builtin_bit_cast(unsigned, __builtin_amdgcn_cvt_scalef32_pk_bf16_fp8(w1, 1.0f / ST8_SCALE, true));
                acc[ni] = MFMA16(a, __builtin_bit_cast(bf16x8, fb), acc[ni]); } }
        __syncthreads();
        {
#pragma unroll
          for (int ks = 0; ks < 2; ++ks) { const bf16x8 a = *(const LAS bf16x8*)(lds + P_OFF + (16 * it + r) * RS + (32 * ks + 8 * g) * 2);
#pragma unroll
              for (int ni = 0; ni < 4; ++ni) { const bf16x8 bb = *(const LAS bf16x8*)(lds + VT_OFF + (64 * nb + 16 * ni + r) * RS + (32 * ks + 8 * g) * 2); acc[ni] = MFMA16(a, bb, acc[ni]); } }
#pragma unroll
          for (int ni = 0; ni < 4; ++ni)
#pragma unroll
              for (int reg = 0; reg < 4; ++reg) *(LAS float*)(lds + OL_OFF + ((16 * it + 4 * g + reg) * OLS + 64 * nb + 16 * ni + r) * 4) = acc[ni][reg];
        }
        __syncthreads();
        {
#pragma unroll
          for (int j = 0; j < 8; ++j) { const int t = 8 * e + j; const f32x2 o = *(const LAS f32x2*)(lds + OL_OFF + (t * OLS + 2 * lane) * 4);
              const float ss = wave_sum(o.x * o.x + o.y * o.y); const float rstd = frsq(ss * (1.0f / 128.0f) + RMS_EPS);
              const f32x2 og = v2bf(ogw[j]); const f32x2 y = o * rstd * gnv * (og * v2rcp(v2exp2(og * (-LOG2E)) + 1.0f));
              *(unsigned short*)(Y + (row0 + t) * D + 512 + 128 * h + 2 * lane) = (unsigned short)__builtin_amdgcn_cvt_pk_fp8_f32(y.x, y.y, 0, false); } }
        }
    }
}

__device__ __forceinline__ void phase_router(const Params& p, LAS unsigned char* ldsb, int l, int dummy = 0) {
    const Ctx cx = make_ctx(ldsb);
    unsigned char* ws = launder(p.ws);
    const bf16_t* X1 = (const bf16_t*)(ws + WS_X1); unsigned char* HN8 = (unsigned char*)(ws + WS_HN8);
    const float* ada = (const float*)(ws + WS_ADA) + (size_t)l * 2 * 6 * D;
    int* LISTA = (int*)(ws + WS_LISTA + (dummy ? ((size_t)64 << 20) : 0)); float* TOKGATE = (float*)(ws + WS_TOKGATE);
    unsigned* gcnt = (unsigned*)(ws + WS_CTL) + CW_CNT + 64 * (l + (dummy ? DEPTH : 0));
    LAS f32x4* wl = (LAS f32x4*)cx.lds;
    LAS int* lcnt = (LAS int*)(cx.lds + MISC_OFF + MS_LCNT); LAS int* gbase = (LAS int*)(cx.lds + MISC_OFF + MS_GBASE);
    const int lane = cx.lane, r = lane & 15, g = lane >> 4;
    const float* gn = p.norm2_g + (size_t)l * D;
    int cur_b = -1;
    for (int chunk = cx.bid; chunk < NTOK / 128; chunk += cx.G) {
        const int b = (chunk * 128) / SEQ;
        const float* sh = ada + (size_t)b * 6 * D + 3 * D; const float* sc = ada + (size_t)b * 6 * D + 4 * D;
        const int tok0 = chunk * 128 + cx.wave * 16;
        const bf16_t* xp = X1 + (size_t)(tok0 + r) * D + 8 * g;
        u32x4 xwa[16], xwb[16];
#pragma unroll
        for (int u = 0; u < 16; ++u) xwa[u] = *(const u32x4*)(xp + 32 * u);
        if (b != cur_b) {
            __syncthreads();
            const f32x4* WLG = (const f32x4*)(ws + WS_WL) + ((size_t)l * 2 + b) * 8192;
            f32x4 wv[16];
#pragma unroll
            for (int i = 0; i < 16; ++i) wv[i] = WLG[cx.tid + 512 * i];
#pragma unroll
            for (int i = 0; i < 16; ++i) wl[cx.tid + 512 * i] = wv[i];
            cur_b = b;
        }
        if (cx.tid < NE) lcnt[cx.tid] = 0;
        __syncthreads();
        f32x4 acc0 = (f32x4){0.f, 0.f, 0.f, 0.f}, acc1 = (f32x4){0.f, 0.f, 0.f, 0.f}; float ss = 0.f;
        { const LAS bf16x8* wlb = (const LAS bf16x8*)cx.lds;
#pragma unroll
          for (int u = 0; u < 16; ++u) xwb[u] = *(const u32x4*)(xp + 32 * (16 + u));
#pragma unroll
          for (int hb = 0; hb < 2; ++hb)
#pragma unroll
              for (int u = 0; u < 16; ++u) { const u32x4 xq = hb == 0 ? xwa[u] : xwb[u]; float xv[8]; unpack8(xq, xv);
#pragma unroll
                  for (int i = 0; i < 8; ++i) ss += xv[i] * xv[i];
                  const bf16x8 xa = __builtin_bit_cast(bf16x8, xq); const int fb = (16 * hb + u) * 256 + lane;
                  acc0 = MFMA16(xa, wlb[fb], acc0); acc1 = MFMA16(xa, wlb[fb + 128], acc1);
                  acc0 = MFMA16(xa, wlb[fb + 64], acc0); acc1 = MFMA16(xa, wlb[fb + 192], acc1); } }
        ss += __shfl_xor(ss, 16); ss += __shfl_xor(ss, 32);
        const float rstd = frsq(ss * (1.0f / D) + RMS_EPS);
        const float* RB = (const float*)(ws + WS_RB) + ((size_t)l * 2 + b) * NE; const float rb0 = RB[r], rb1 = RB[16 + r];
        int es = 0; float gs = 0.f;
#pragma unroll
        for (int reg = 0; reg < 4; ++reg) {
            const float rs = __shfl(rstd, 4 * g + reg);
            float v0 = acc0[reg] * rs + rb0, v1 = acc1[reg] * rs + rb1;
            float tv[4]; int ti[4];
#pragma unroll
            for (int k = 0; k < 4; ++k) { const bool up = v1 > v0; float bv = up ? v1 : v0; int bi = up ? 16 + r : r;
#define RT_STEP(CTRL) do { const float ov = dpp_f<CTRL>(bv); const int oi = dpp_i<CTRL>(bi); const bool take = ov > bv || (ov == bv && oi < bi); bv = take ? ov : bv; bi = take ? oi : bi; } while (0)
                RT_STEP(0xB1); RT_STEP(0x4E); RT_STEP(0x141); RT_STEP(0x140);
#undef RT_STEP
                tv[k] = bv; ti[k] = bi; v0 = (bi == r) ? -3.0e38f : v0; v1 = (bi == 16 + r) ? -3.0e38f : v1; }
            const float e1 = __expf(tv[1] - tv[0]), e2 = __expf(tv[2] - tv[0]), e3 = __expf(tv[3] - tv[0]); const float inv = 1.0f / (1.0f + e1 + e2 + e3);
            if ((r >> 2) == reg) { const int k = r & 3; es = k == 0 ? ti[0] : k == 1 ? ti[1] : k == 2 ? ti[2] : ti[3]; gs = (k == 0 ? 1.0f : k == 1 ? e1 : k == 2 ? e2 : e3) * inv; }
        }
        const int lp = __hip_atomic_fetch_add(lcnt + es, 1, __ATOMIC_RELAXED, __HIP_MEMORY_SCOPE_WORKGROUP);
        __syncthreads();
        unsigned gb = 0u; if (cx.tid < NE) gb = atomicAdd(gcnt + cx.tid, (unsigned)lcnt[cx.tid]);
        { float a8[2][8], s8[2][8];
#pragma unroll
          for (int j = 0; j < 2; ++j)
#pragma unroll
              for (int h = 0; h < 2; ++h) { const int c = 8 * lane + 512 * j + 4 * h; const f32x4 gg4 = *(const f32x4*)(gn + c), sc4 = *(const f32x4*)(sc + c), sh4 = *(const f32x4*)(sh + c);
#pragma unroll
                  for (int i = 0; i < 4; ++i) { a8[j][4 * h + i] = gg4[i] * (sc4[i] + 1.0f); s8[j][4 * h + i] = sh4[i]; } }
          for (int i0 = 0; i0 < 16; i0 += 4) { u32x4 xw[4][2];
#pragma unroll
              for (int u = 0; u < 4; ++u)
#pragma unroll
                  for (int j = 0; j < 2; ++j) xw[u][j] = *(const u32x4*)(X1 + (size_t)(tok0 + i0 + u) * D + 8 * lane + 512 * j);
#pragma unroll
              for (int u = 0; u < 4; ++u) { const float rs = __shfl(rstd, i0 + u);
#pragma unroll
                  for (int j = 0; j < 2; ++j) { float xv[8], o[8]; unpack8(xw[u][j], xv);
#pragma unroll
                      for (int i = 0; i < 8; ++i) o[i] = (xv[i] * rs) * a8[j][i] + s8[j][i];
                      *(u32x2*)(HN8 + (size_t)(tok0 + i0 + u) * D + 8 * lane + 512 * j) = pack8_fp8(o); } } } }
        if (cx.tid < NE) gbase[cx.tid] = (int)gb;
        __syncthreads();
        { const int pos = gbase[es] + lp; LISTA[(size_t)es * NASSIGN + pos] = chunk * 512 + cx.tid; TOKGATE[(size_t)chunk * 512 + cx.tid] = gs; }
    }
}

__device__ __forceinline__ void build_expert_tables(const Params& p, const Ctx& cx, int l) {
    const unsigned* gcnt = (const unsigned*)(launder(p.ws) + WS_CTL) + CW_CNT + 64 * l;
    LAS int* pstart = (LAS int*)(cx.lds + MISC_OFF + MS_PSTART); LAS int* cnt = (LAS int*)(cx.lds + MISC_OFF + MS_CNT);
    LAS unsigned char* blke = (LAS unsigned char*)(cx.lds + MISC_OFF + MS_BLKE); LAS int* nm = (LAS int*)(cx.lds + MISC_OFF + MS_NM);
    if (cx.tid < NE) cnt[cx.tid] = (int)gcnt[cx.tid];
    __syncthreads();
    if (cx.tid == 0) { int run = 0; for (int e = 0; e < NE; ++e) { pstart[e] = run; run += (cnt[e] + 255) & ~255; } pstart[NE] = run; nm[0] = run >> 8; }
    __syncthreads();
    if (cx.tid < NE) { const int b0 = pstart[cx.tid] >> 8, b1 = pstart[cx.tid + 1] >> 8; for (int b = b0; b < b1; ++b) blke[b] = (unsigned char)cx.tid; }
    __syncthreads();
}

__device__ __forceinline__ int bias_tab_off(int ui) { return ui < 16 ? BIAS_OFF + ui * 512 : IDX_OFF + 17 * 512 + (ui - 16) * 512; }
template <bool WANT_TOK, class Sched>
__device__ __forceinline__ bool build_row_tables(const Ctx& cx, const Sched& S, unsigned char* ws, const float* bias_l) {
    LAS int* pstart = (LAS int*)(cx.lds + MISC_OFF + MS_PSTART); LAS int* cnt = (LAS int*)(cx.lds + MISC_OFF + MS_CNT);
    LAS int* udesc = (LAS int*)(cx.lds + MISC_OFF + MS_LE);
    LAS int* nun = (LAS int*)(cx.lds + MISC_OFF + MS_LPOS);
    const int* LISTA = (const int*)(ws + WS_LISTA);
    constexpr int MU = WANT_TOK ? MAXU : MAXU / 2;
    if (cx.tid < MAXU) { pg8::Unit u; int base = 0, nv = -1, ue = 0, upn = 0;
        if (S.next(cx.tid, u)) { const int pos0 = (u.pm - (pstart[u.e] >> 8)) * 256; base = u.e * NASSIGN + pos0; nv = cnt[u.e] - pos0; nv = nv > 256 ? 256 : nv; ue = u.e; upn = u.pn; }
        udesc[4 * cx.tid] = base; udesc[4 * cx.tid + 1] = nv; udesc[4 * cx.tid + 2] = ue; udesc[4 * cx.tid + 3] = upn; }
    if (cx.tid == 0) { pg8::Unit u; nun[0] = S.next(WANT_TOK ? 17 : MU, u) ? 1 : 0; }
    __syncthreads();
    const bool ok = nun[0] == 0;
    const int r = cx.tid & 255, u0 = cx.tid >> 8;
    int v[MU / 2]; float bvv[MU / 2];
#pragma unroll
    for (int k = 0; k < MU / 2; ++k) { const int ui = 2 * k + u0, nv = udesc[4 * ui + 1], ue = udesc[4 * ui + 2], upn = udesc[4 * ui + 3];
        v[k] = (nv >= 0 && r < nv) ? LISTA[udesc[4 * ui] + r] : -1;
        bvv[k] = nv >= 0 ? (WANT_TOK ? bias_l[(size_t)ue * 2048 + (r < 128 ? 128 * upn + r : 1024 + 128 * upn + (r - 128))] : bias_l[(size_t)ue * D + 256 * upn + r]) : 0.f; }
#pragma unroll
    for (int k = 0; k < MU / 2; ++k) { const int ui = 2 * k + u0;
        if (udesc[4 * ui + 1] >= 0) {
            if (WANT_TOK) ((LAS unsigned short*)(cx.lds + IDX_OFF))[ui * 256 + r] = (unsigned short)(v[k] >= 0 ? (v[k] >> 2) : NTOK);
            else ((LAS int*)(cx.lds + IDX_OFF))[ui * 256 + r] = v[k];
            *(LAS bf16_t*)(cx.lds + bias_tab_off(ui) + 2 * r) = (bf16_t)f2bf(bvv[k]); } }
    __syncthreads();
    return ok;
}

constexpr int CROWS = 4;
__device__ __forceinline__ void phase_combine(const Params& p, LAS unsigned char* ldsb, int l, bool poison) {
    const Ctx cx = make_ctx(ldsb);
    unsigned char* ws = launder(p.ws);
    const bf16_t* X1 = (const bf16_t*)(ws + WS_X1); bf16_t* X0 = (bf16_t*)(ws + WS_X0); const unsigned char* SLOT = (const unsigned char*)(ws + WS_SLOT); bf16_t* HN = (bf16_t*)(ws + WS_HN);
    const float* TOKGATE = (const float*)(ws + WS_TOKGATE);
    const float* ada = (const float*)(ws + WS_ADA) + (size_t)l * 2 * 6 * D;
    const float* adan = (const float*)(ws + WS_ADA) + (size_t)(l + 1) * 2 * 6 * D;
    const int lane = cx.lane;
    for (int row0 = CROWS * cx.gw; row0 < NTOK; row0 += CROWS * cx.NGW) {
        const int b = row0 / SEQ; const float* g2 = ada + (size_t)b * 6 * D + 5 * D;
        u32x4 xw[CROWS][2]; u32x2 sw[CROWS][2][4];
        f32x4 gt[CROWS];
#pragma unroll
        for (int u = 0; u < CROWS; ++u) gt[u] = *(const f32x4*)(TOKGATE + (size_t)(row0 + u) * 4);
#pragma unroll
        for (int u = 0; u < CROWS; ++u)
#pragma unroll
            for (int j = 0; j < 2; ++j) { const int c = 8 * lane + 512 * j;
                xw[u][j] = __builtin_nontemporal_load((const u32x4*)(X1 + (size_t)(row0 + u) * D + c));
#pragma unroll
                for (int k = 0; k < 4; ++k) sw[u][j][k] = __builtin_nontemporal_load((const u32x2*)(SLOT + ((size_t)(row0 + u) * 4 + k) * D + c)); }
#pragma unroll
        for (int u = 0; u < CROWS; ++u) { const int row = row0 + u; float v[2][8];
#pragma unroll
            for (int j = 0; j < 2; ++j) { const int c = 8 * lane + 512 * j; float m[8], x[8];
#pragma unroll
                for (int i = 0; i < 8; ++i) m[i] = 0.f;
#pragma unroll
                for (int k = 0; k < 4; ++k) { float sv[8]; unpack8_fp8(sw[u][j][k], sv); const float gk = gt[u][k];
#pragma unroll
                    for (int i = 0; i < 8; ++i) m[i] += sv[i] * gk; }
                unpack8(xw[u][j], x);
                const f32x4 ga = *(const f32x4*)(g2 + c), gb = *(const f32x4*)(g2 + c + 4);
#pragma unroll
                for (int i = 0; i < 4; ++i) { v[j][i] = x[i] + ga[i] * m[i]; v[j][4 + i] = x[4 + i] + gb[i] * m[4 + i]; } }
            if (l < DEPTH - 1) {
#pragma unroll
                for (int j = 0; j < 2; ++j) *(u32x4*)(X0 + (size_t)row * D + 8 * lane + 512 * j) = pack8(v[j]);
                norm_mod_store8(v, p.norm1_g + (size_t)(l + 1) * D, adan + (size_t)b * 6 * D + 0 * D, adan + (size_t)b * 6 * D + 1 * D, HN + (size_t)row * D, lane);
            } else {
                float ss = 0.f;
#pragma unroll
                for (int j = 0; j < 2; ++j)
#pragma unroll
                    for (int i = 0; i < 8; ++i) ss += v[j][i] * v[j][i];
                const float rstd = frsq(wave_sum(ss) * (1.0f / D) + RMS_EPS);
#pragma unroll
                for (int j = 0; j < 2; ++j)
#pragma unroll
                    for (int h = 0; h < 2; ++h) { const int c = 8 * lane + 512 * j + 4 * h; const f32x4 fg = *(const f32x4*)(p.final_g + c);
                        f32x4 o = (f32x4){v[j][4 * h] * rstd * fg[0], v[j][4 * h + 1] * rstd * fg[1], v[j][4 * h + 2] * rstd * fg[2], v[j][4 * h + 3] * rstd * fg[3]};
                        if (poison) { const float q = __builtin_nanf(""); o = (f32x4){q, q, q, q}; }
                        *(f32x4*)(p.out + (size_t)row * D + c) = o; }
            }
        }
    }
}

constexpr int NPH = 2 + 9 * DEPTH;
__global__ void __launch_bounds__(512, 2) mk_fwd(Params p) {
    extern __shared__ __attribute__((aligned(16))) unsigned char lds_raw[];
    LAS unsigned char* const ldsb = (LAS unsigned char*)lds_raw;
    volatile LAS unsigned* barst = (volatile LAS unsigned*)(ldsb + MISC_OFF + MS_BAR);
    if (threadIdx.x < 4) barst[threadIdx.x] = 0u;
    __syncthreads();
    const int lo = p.ph_lo, hi = p.ph_hi;
    unsigned* barw = (unsigned*)(p.ws + WS_CTL) + CW_BAR;
    XcdBarrier bar; bar.bar = barw; bar.x = 0; bar.st = barst;
    if (hi - lo > 1) bar = xcd_barrier_post(barw, barst);
#define IN(k) (lo <= (k) && (k) < hi)
#define SEAM(k) do { if (IN(k) && IN((k) + 1)) xcd_barrier(bar); } while (0)

    if (IN(0)) for (int rep = 0; rep < REPS(0); ++rep) phase_prologue(p, ldsb);
    SEAM(0);
    if (IN(1)) for (int rep = 0; rep < REPS(1); ++rep) phase_norm1_first(p, ldsb);
    SEAM(1);
    for (int l = 0; l < DEPTH; ++l) {
        const int base = 2 + 9 * l;
        if (IN(base + 0)) for (int rep = 0; rep < REPS(2); ++rep) {
            const Ctx cx = make_ctx(ldsb); unsigned char* ws = launder(p.ws);
            pg8::Gemm g{(const bf16_t*)(ws + WS_HN), (const bf16_t*)(ws + WS_WIN) + (size_t)l * NPROJ * D, NTOK, NPROJ, D, 0};
            pg8::StaticOrder S; S.init(NTOK / 256, NPROJ, cx.G, cx.bid);
            pg8::EpiProj E{(bf16_t*)(ws + WS_PROJ)};
            const bool conv_first = ((cx.bid >> 3) & 1) != 0;
            if (conv_first && rep == 0) convert_expert_weights(p, cx, ws, l, 0);
            pg8::gemm_phase<pg8::EpiProj, pg8::StaticOrder>(cx.lds, g, S, E, cx.tid);
            if (!conv_first && rep == 0) convert_expert_weights(p, cx, ws, l, 0);
            if (rep == 0) convert_tail(p, cx, ws, l, 0);
        }
        SEAM(base + 0);
        if (IN(base + 1)) for (int rep = 0; rep < REPS(3); ++rep) phase_hgrn_local(p, ldsb, l);
        SEAM(base + 1);
        if (IN(base + 2)) for (int rep = 0; rep < REPS(4); ++rep) phase_hgrn_scan(p, ldsb);
        SEAM(base + 2);
        if (IN(base + 3)) for (int rep = 0; rep < REPS(5); ++rep) phase_hgrn_out(p, ldsb, l);
        SEAM(base + 3);
        if (IN(base + 4)) for (int rep = 0; rep < REPS(6); ++rep) {
            const Ctx cx = make_ctx(ldsb); unsigned char* ws = launder(p.ws);
            const float* ada_l = (const float*)(ws + WS_ADA) + (size_t)l * 2 * 6 * D;
            pg8::Gemm g{(const bf16_t*)(ws + WS_Y), (const bf16_t*)(ws + WS_WOUT + (size_t)l * D * D), NTOK, D, D / 2, 0};
            pg8::StaticOrder S; S.init(NTOK / 256, D, cx.G, cx.bid);
            if (l == 0) { pg8::EpiResidual<true> E{(const void*)p.x, (bf16_t*)(ws + WS_X1), ada_l + 2 * D, 1.0f / WGU_SCALE};
                pg8::gemm_phase<pg8::EpiResidual<true>, pg8::StaticOrder, true, true>(cx.lds, g, S, E, cx.tid, nullptr); }
            else { pg8::EpiResidual<false> E{(const void*)(ws + WS_X0), (bf16_t*)(ws + WS_X1), ada_l + 2 * D, 1.0f / WGU_SCALE};
                pg8::gemm_phase<pg8::EpiResidual<false>, pg8::StaticOrder, true, true>(cx.lds, g, S, E, cx.tid, nullptr); }
        }
        SEAM(base + 4);
        if (IN(base + 5)) for (int rep = 0; rep < REPS(7); ++rep) phase_router(p, ldsb, l, rep);
        SEAM(base + 5);
        if (IN(base + 6)) for (int rep = 0; rep < REPS(9); ++rep) {
            const Ctx cx = make_ctx(ldsb); unsigned char* ws = launder(p.ws);
            build_expert_tables(p, cx, l);
            const int nmb = *(LAS int*)(cx.lds + MISC_OFF + MS_NM);
            pg8::Gemm g{(const bf16_t*)(ws + WS_HN8), (const bf16_t*)(ws + WS_WGU + (size_t)l * NE * 2048 * D), nmb * 256, 2048, D / 2, (size_t)2048 * D};
            pg8::GroupedOrder S; S.init(nmb, 2048, cx.G, cx.bid); S.blk_e = (const LAS unsigned char*)(cx.lds + MISC_OFF + MS_BLKE);
            const bool conv_first = ((cx.bid >> 3) & 1) != 0;
            const int r_hi = (nmb * 8) % cx.G;
            if (conv_first && rep == 0) convert_expert_weights(p, cx, ws, l, 1, r_hi);
            if (build_row_tables<true>(cx, S, ws, p.b_gu + (size_t)l * NE * 2048)) {
                pg8::EpiGateUp E{(unsigned char*)(ws + WS_ACT), (const LAS unsigned char*)cx.lds, 1.0f / WGU_SCALE};
                pg8::gemm_phase<pg8::EpiGateUp, pg8::GroupedOrder, true, true>(cx.lds, g, S, E, cx.tid, (const LAS unsigned short*)(cx.lds + IDX_OFF));
            }
            if (!conv_first && rep == 0) convert_expert_weights(p, cx, ws, l, 1, r_hi);
            if (rep == 0) convert_tail(p, cx, ws, l, 1);
        }
        SEAM(base + 6);
        if (IN(base + 7)) for (int rep = 0; rep < REPS(10); ++rep) {
            const Ctx cx = make_ctx(ldsb); unsigned char* ws = launder(p.ws);
            build_expert_tables(p, cx, l);
            const int nmb = *(LAS int*)(cx.lds + MISC_OFF + MS_NM);
            pg8::Gemm g{(const bf16_t*)(ws + WS_ACT), (const bf16_t*)(ws + WS_WDN + (size_t)l * NE * D * D), nmb * 256, D, D / 2, (size_t)D * D};
            pg8::GroupedOrder S; S.init(nmb, D, cx.G, cx.bid); S.blk_e = (const LAS unsigned char*)(cx.lds + MISC_OFF + MS_BLKE);
            if (build_row_tables<false>(cx, S, ws, p.b_down + (size_t)l * NE * D)) {
                pg8::EpiDown E{(unsigned char*)(ws + WS_SLOT), (const LAS unsigned char*)cx.lds, (const LAS int*)(cx.lds + IDX_OFF), 1.0f / WGU_SCALE};
                pg8::gemm_phase<pg8::EpiDown, pg8::GroupedOrder, true, true>(cx.lds, g, S, E, cx.tid, nullptr);
            }
        }
        SEAM(base + 7);
        if (IN(base + 8)) {
            const bool poison = (l == DEPTH - 1) && (__hip_atomic_load(barw + XB_TMO, __ATOMIC_RELAXED, __HIP_MEMORY_SCOPE_AGENT) != 0u);
            for (int rep = 0; rep < REPS(11); ++rep) phase_combine(p, ldsb, l, poison);
        }
        if (l < DEPTH - 1) SEAM(base + 8);
    }
#undef IN
#undef SEAM
}

extern "C" void kernel_launch(void* const* d_in, const int* in_sizes, int n_in, void* d_out, int out_size, void* d_ws, size_t ws_size, hipStream_t stream) {
    static int grid = 0;
    if (grid == 0) {
        if (n_in != 19 || in_sizes[0] != NTOK * D || out_size != NTOK * D || ws_size < WS_END) {
            fprintf(stderr, "kernel_launch: unexpected shapes (n_in %d, in0 %d, out %d, ws %zu need %zu); nothing launched\n", n_in, n_in > 0 ? in_sizes[0] : -1, out_size, ws_size, (size_t)WS_END); grid = -1; return; }
        int dev = 0, cus = 0, per_cu = 0;
        if (hipGetDevice(&dev) != hipSuccess || hipDeviceGetAttribute(&cus, hipDeviceAttributeMultiprocessorCount, dev) != hipSuccess) { fprintf(stderr, "kernel_launch: device query failed\n"); grid = -1; return; }
        if (hipFuncSetAttribute((const void*)mk_fwd, hipFuncAttributeMaxDynamicSharedMemorySize, LDS_BYTES) != hipSuccess) { fprintf(stderr, "kernel_launch: hipFuncSetAttribute failed\n"); grid = -1; return; }
        if (hipOccupancyMaxActiveBlocksPerMultiprocessor(&per_cu, (const void*)mk_fwd, 512, LDS_BYTES) != hipSuccess || per_cu < 1)
            fprintf(stderr, "kernel_launch: note: occupancy query reports %d workgroups per CU\n", per_cu);
        (void)hipGetLastError();
        grid = cus;
    }
    if (grid < 0) return;
    if (hipMemsetAsync((char*)d_ws + WS_CTL, 0, CTL_ZERO_BYTES, stream) != hipSuccess) { fprintf(stderr, "kernel_launch: memset failed\n"); return; }
    Params p{};
    p.x = (const float*)d_in[0]; p.c = (const float*)d_in[1]; p.w_ada = (const float*)d_in[2]; p.b_ada = (const float*)d_in[3]; p.norm1_g = (const float*)d_in[4]; p.norm2_g = (const float*)d_in[5];
    p.w_in = (const float*)d_in[6]; p.conv_w = (const float*)d_in[7]; p.conv_norm_g = (const float*)d_in[8]; p.lower_bounds = (const float*)d_in[9]; p.hgrn_norm_g = (const float*)d_in[10];
    p.w_out = (const float*)d_in[11]; p.w_router = (const float*)d_in[12]; p.b_router = (const float*)d_in[13]; p.w_gu = (const float*)d_in[14]; p.b_gu = (const float*)d_in[15];
    p.w_down = (const float*)d_in[16]; p.b_down = (const float*)d_in[17]; p.final_g = (const float*)d_in[18];
    p.out = (float*)d_out; p.ws = (unsigned char*)d_ws;
#if MK_SPLIT
    for (int k = 0; k < NPH; ++k) { p.ph_lo = k; p.ph_hi = k + 1; hipLaunchKernelGGL(mk_fwd, dim3(grid), dim3(512), LDS_BYTES, stream, p); }
#else
    p.ph_lo = 0; p.ph_hi = NPH;
    hipLaunchKernelGGL(mk_fwd, dim3(grid), dim3(512), LDS_BYTES, stream, p);
#endif
    const hipError_t le = hipPeekAtLastError();
    if (le != hipSuccess) fprintf(stderr, "kernel_launch: launch failed: %s\n", hipGetErrorName(le));
}
```

```cpp
#include <hip/hip_runtime.h>
#include <cstdio>
#include <cstdint>

#ifndef MK_SPLIT
#define MK_SPLIT 0
#endif
#ifndef PROBE_REP
#define PROBE_REP 0
#endif
#define REPS(k) (1 + ((PROBE_REP >> (k)) & 1))

#define GAS __attribute__((address_space(1)))
#define LAS __attribute__((address_space(3)))
typedef unsigned short bf16_t;
typedef short bf16x8 __attribute__((ext_vector_type(8)));
typedef float f32x4 __attribute__((ext_vector_type(4)));
typedef float f32x2 __attribute__((ext_vector_type(2)));
typedef unsigned u32x4 __attribute__((ext_vector_type(4)));
typedef unsigned u32x2 __attribute__((ext_vector_type(2)));

constexpr int D = 1024, NBATCH = 2, SEQ = 16384, NTOK = NBATCH * SEQ, DEPTH = 4;
constexpr int NPROJ = 3584, NE = 32, TOPK = 4, NASSIGN = NTOK * TOPK;
constexpr int CHUNK = 64, NCHUNK = SEQ / CHUNK, NHEAD = 4, DK = 128;
constexpr int NUNIT = NBATCH * NHEAD * NCHUNK;
constexpr int MAXMBLK = NASSIGN / 256 + NE;
constexpr int PROWS = MAXMBLK * 256;
constexpr float RMS_EPS = 1e-6f;
constexpr float WGU_SCALE = 32.0f;
constexpr int NPO = 3072;
constexpr int PC_U = 0, PC_CB = 512, PC_Q = 1024, PC_F = 1536, PC_I = 2048, PC_OG = 2560;
__host__ __device__ constexpr int win_row(int n) { return n < 512 ? 1024 + n : n < 1024 ? 256 * ((n - 512) >> 7) + ((n - 512) & 127) : n < 1536 ? 256 * ((n - 1024) >> 7) + 128 + ((n - 1024) & 127) : n; }

constexpr size_t MiB = 1u << 20;
constexpr size_t WS_CTL = 0, CTL_ZERO_BYTES = 1 * MiB;
constexpr size_t WS_ADA = 1 * MiB;
constexpr size_t WS_LB = 1 * MiB + 512 * 1024;
constexpr size_t WS_RB = 1 * MiB + 768 * 1024;
constexpr size_t WS_WL = 1121 * MiB;
constexpr size_t WS_WIN = 2 * MiB;
constexpr size_t WS_WOUT = 30 * MiB;
constexpr size_t WS_WGU = 38 * MiB;
constexpr size_t WS_WDN = 550 * MiB;
constexpr size_t WS_HN = 806 * MiB;
constexpr size_t WS_PROJ = 872 * MiB;
constexpr size_t WS_U = 1096 * MiB;
constexpr size_t WS_CARRY = 1112 * MiB;
constexpr size_t WS_SEGD = 1120 * MiB;
constexpr size_t WS_DEC = 1224 * MiB;
constexpr size_t WS_ST8 = 1321 * MiB;
constexpr size_t WS_S = 1225 * MiB;
constexpr size_t WS_Y = 1289 * MiB;
constexpr size_t WS_X0 = 1353 * MiB;
constexpr size_t WS_X1 = 1481 * MiB;
constexpr size_t WS_LISTA = 1609 * MiB;
constexpr size_t WS_HN8 = 1720 * MiB;
constexpr size_t WS_ACT = 1881 * MiB;
constexpr size_t WS_SLOT = 2153 * MiB;
constexpr size_t WS_PADSLOT = 2409 * MiB;
constexpr size_t WS_PADGATE = 2410 * MiB;
constexpr size_t WS_TOKE = 2411 * MiB;
constexpr size_t WS_TOKPOS = 2411 * MiB + 512 * 1024;
constexpr size_t WS_TOKGATE = 2412 * MiB;
constexpr size_t WS_END = 2413 * MiB;
constexpr int CW_CNT = 1024;
constexpr int CW_BAR = 4096;
constexpr int CW_QUEUE = 8192;

constexpr int RING_BYTES = 131072;
constexpr int MISC_OFF = 139264;
constexpr int BIAS_OFF = 131072;
constexpr int IDX_OFF = 147456;
constexpr int MAXU = 32;
constexpr int LDS_BYTES = 163840;
constexpr int MS_BAR = 0;
constexpr int MS_PSTART = 64;
constexpr int MS_CNT = 256;
constexpr int MS_LCNT = 512;
constexpr int MS_GBASE = 768;
constexpr int MS_BLKE = 1024;
constexpr int MS_LE = 2048;
constexpr int MS_LPOS = 4096;
constexpr int MS_NM = 6144;

__device__ __forceinline__ unsigned pk2(float lo, float hi) { unsigned r; asm("v_cvt_pk_bf16_f32 %0, %1, %2" : "=v"(r) : "v"(lo), "v"(hi)); return r; }
__device__ __forceinline__ unsigned f2bf(float f) { return pk2(f, 0.f) & 0xffffu; }
__device__ __forceinline__ unsigned bf_rne(float f) { unsigned u = __float_as_uint(f); u += 0x7fffu + ((u >> 16) & 1u); return u >> 16; }
__device__ __forceinline__ float frcp(float x) { return __builtin_amdgcn_rcpf(x); }
__device__ __forceinline__ f32x2 v2exp2(f32x2 x) { return (f32x2){__builtin_amdgcn_exp2f(x.x), __builtin_amdgcn_exp2f(x.y)}; }
__device__ __forceinline__ f32x2 v2log2(f32x2 x) { return (f32x2){__builtin_amdgcn_logf(x.x), __builtin_amdgcn_logf(x.y)}; }
__device__ __forceinline__ f32x2 v2rcp(f32x2 x) { return (f32x2){__builtin_amdgcn_rcpf(x.x), __builtin_amdgcn_rcpf(x.y)}; }
__device__ __forceinline__ f32x2 v2bf(unsigned w) { return (f32x2){__uint_as_float(w << 16), __uint_as_float(w & 0xffff0000u)}; }
__device__ __forceinline__ unsigned pk2v(f32x2 v) { return pk2(v.x, v.y); }
constexpr float LOG2E = 1.4426950408889634f;
__device__ __forceinline__ float frsq(float x) { return __builtin_amdgcn_rsqf(x); }
__device__ __forceinline__ float bflo(unsigned w) { return __uint_as_float(w << 16); }
__device__ __forceinline__ float bfhi(unsigned w) { return __uint_as_float(w & 0xffff0000u); }
template <int CTRL> __device__ __forceinline__ float dpp_f(float v) { return __int_as_float(__builtin_amdgcn_update_dpp(0, __float_as_int(v), CTRL, 0xf, 0xf, false)); }
template <int CTRL> __device__ __forceinline__ int dpp_i(int v) { return __builtin_amdgcn_update_dpp(0, v, CTRL, 0xf, 0xf, false); }
__device__ __forceinline__ float row16_sum(float v) {
    v += dpp_f<0x128>(v); v += dpp_f<0x124>(v); v += dpp_f<0x122>(v); v += dpp_f<0x121>(v); return v; }
__device__ __forceinline__ float oct_sum(float v) {
    v += dpp_f<0xB1>(v); v += dpp_f<0x4E>(v); v += dpp_f<0x141>(v); return v; }
__device__ __forceinline__ float wave_sum(float v) { v = row16_sum(v); v += __shfl_xor(v, 16); v += __shfl_xor(v, 32); return v; }
__device__ __forceinline__ void unpack8(const u32x4 w, float (&o)[8]) { o[0] = bflo(w.x); o[1] = bfhi(w.x); o[2] = bflo(w.y); o[3] = bfhi(w.y); o[4] = bflo(w.z); o[5] = bfhi(w.z); o[6] = bflo(w.w); o[7] = bfhi(w.w); }
__device__ __forceinline__ u32x4 pack8(const float (&o)[8]) { u32x4 w; w.x = pk2(o[0], o[1]); w.y = pk2(o[2], o[3]); w.z = pk2(o[4], o[5]); w.w = pk2(o[6], o[7]); return w; }
__device__ __forceinline__ u32x2 pack8_fp8(const float (&o)[8]) { int lo = 0, hi = 0;
    lo = __builtin_amdgcn_cvt_pk_fp8_f32(o[0], o[1], lo, false); lo = __builtin_amdgcn_cvt_pk_fp8_f32(o[2], o[3], lo, true);
    hi = __builtin_amdgcn_cvt_pk_fp8_f32(o[4], o[5], hi, false); hi = __builtin_amdgcn_cvt_pk_fp8_f32(o[6], o[7], hi, true);
    return (u32x2){(unsigned)lo, (unsigned)hi}; }
__device__ __forceinline__ void unpack8_fp8(const u32x2 w, float (&o)[8]) {
    const f32x2 a = __builtin_amdgcn_cvt_pk_f32_fp8((int)w.x, false), b = __builtin_amdgcn_cvt_pk_f32_fp8((int)w.x, true);
    const f32x2 c = __builtin_amdgcn_cvt_pk_f32_fp8((int)w.y, false), d = __builtin_amdgcn_cvt_pk_f32_fp8((int)w.y, true);
    o[0] = a.x; o[1] = a.y; o[2] = b.x; o[3] = b.y; o[4] = c.x; o[5] = c.y; o[6] = d.x; o[7] = d.y; }
#define LDS_WAIT() asm volatile("s_waitcnt lgkmcnt(0)" ::: "memory")

namespace pg8 {
#define PG8_LAS __attribute__((address_space(3)))
constexpr int BM = 256, BK = 64, HALF = 128, HTB = HALF * BK * 2, STAGE_BYTES = 8 * HTB, NXCD = 8, WGM = 8;
__host__ __device__ __forceinline__ int lds_byte(int r, int c) { const int st = (r >> 4) * 2 + (c >> 5), rr = r & 15, cc = c & 31, ob = rr * 64 + cc * 2; return st * 1024 + (ob ^ (((ob >> 9) & 1) << 5)); }
__host__ __device__ __forceinline__ void stage_rc(int b, int& R, int& C) { const int st = b / 1024, sb = b % 1024, swz = sb ^ (((sb >> 9) & 1) << 5); R = (st >> 1) * 16 + swz / 64; C = (st & 1) * 32 + (swz % 64) / 2; }
__host__ __device__ __forceinline__ int perm32(int rho) { const int n = rho >> 4, i = rho & 15; return 8 * (i >> 2) + 4 * n + (i & 3); }

struct Unit { int pm, pn, e; };
struct Gemm { const bf16_t* A; const bf16_t* Bt; int M, N, K; size_t bgstride; };

struct StaticOrder {
    int nM, nN, nwg, G, c;
    __device__ void init(int nM_, int N, int G_, int c_) { nM = nM_; nN = N / BM; nwg = nM * nN; G = G_; c = c_; }
    __device__ bool next(int i, Unit& u) const {
        const long L = (long)i * G + c; if (L >= nwg) return false;
        int wgid = (int)L; { const int q = nwg / NXCD, r = nwg % NXCD, xcd = wgid % NXCD, off = wgid / NXCD; wgid = (xcd < r ? xcd * (q + 1) : r * (q + 1) + (xcd - r) * q) + off; }
        const int nig = WGM * nN, gid = wgid / nig, fm = gid * WGM, gsz = (nM - fm) < WGM ? (nM - fm) : WGM;
        u.pm = fm + ((wgid % nig) % gsz); u.pn = (wgid % nig) / gsz; u.e = 0; return true;
    }
};
struct GroupedOrder : StaticOrder {
    const PG8_LAS unsigned char* blk_e;
    __device__ bool next(int i, Unit& u) const { if (!StaticOrder::next(i, u)) return false; u.e = (int)blk_e[u.pm]; return true; }
};

__device__ __forceinline__ unsigned cvt_pk_bf16(float lo, float hi) { unsigned r; asm volatile("v_cvt_pk_bf16_f32 %0, %1, %2" : "=v"(r) : "v"(lo), "v"(hi)); return r; }

struct EpiProj {
    static constexpr bool PERM = true, WIDE = false;
    bf16_t* O;
    __device__ __forceinline__ void operator()(const f32x4 (&acc)[2][2][4][2], const Unit& u, int wr, int wc, int fr, int fq, int) const {
        const int row0 = u.pm * BM + wr * 64 + fr, c0 = wc * 32 + 8 * fq;
        if (u.pn < 4) {
#pragma unroll
            for (int ai = 0; ai < 2; ++ai)
#pragma unroll
                for (int m = 0; m < 4; ++m) { const f32x4 v0 = acc[ai][0][m][0] * acc[ai][1][m][0], v1 = acc[ai][0][m][1] * acc[ai][1][m][1];
                    u32x4 w; w.x = cvt_pk_bf16(v0[0], v0[1]); w.y = cvt_pk_bf16(v0[2], v0[3]); w.z = cvt_pk_bf16(v1[0], v1[1]); w.w = cvt_pk_bf16(v1[2], v1[3]);
                    *(u32x4*)(O + (size_t)(row0 + ai * HALF + m * 16) * NPO + 128 * u.pn + c0) = w; }
        } else {
            const int col0 = 512 + (u.pn - 4) * BM + c0;
#pragma unroll
            for (int ai = 0; ai < 2; ++ai)
#pragma unroll
                for (int m = 0; m < 4; ++m) { bf16_t* rowp = O + (size_t)(row0 + ai * HALF + m * 16) * NPO + col0;
#pragma unroll
                    for (int bj = 0; bj < 2; ++bj) { const f32x4 v0 = acc[ai][bj][m][0], v1 = acc[ai][bj][m][1];
                        u32x4 w; w.x = cvt_pk_bf16(v0[0], v0[1]); w.y = cvt_pk_bf16(v0[2], v0[3]); w.z = cvt_pk_bf16(v1[0], v1[1]); w.w = cvt_pk_bf16(v1[2], v1[3]);
                        *(u32x4*)(rowp + bj * HALF) = w; } }
        }
    }
};
struct EpiStoreBf16 {
    static constexpr bool PERM = true, WIDE = false;
    bf16_t* O; int ldc;
    __device__ __forceinline__ void operator()(const f32x4 (&acc)[2][2][4][2], const Unit& u, int wr, int wc, int fr, int fq, int) const {
        const int row0 = u.pm * BM + wr * 64 + fr, col0 = u.pn * BM + wc * 32 + 8 * fq;
#pragma unroll
        for (int ai = 0; ai < 2; ++ai)
#pragma unroll
            for (int m = 0; m < 4; ++m) { bf16_t* rowp = O + (size_t)(row0 + ai * HALF + m * 16) * ldc + col0;
#pragma unroll
                for (int bj = 0; bj < 2; ++bj) { const f32x4 v0 = acc[ai][bj][m][0], v1 = acc[ai][bj][m][1];
                    u32x4 w; w.x = cvt_pk_bf16(v0[0], v0[1]); w.y = cvt_pk_bf16(v0[2], v0[3]); w.z = cvt_pk_bf16(v1[0], v1[1]); w.w = cvt_pk_bf16(v1[2], v1[3]);
                    *(u32x4*)(rowp + bj * HALF) = w; } }
    }
};
template <bool IN_F32> struct EpiResidual {
    static constexpr bool PERM = true, WIDE = false;
    const void* xin; bf16_t* xout; const float* gvec; float wsc;
    __device__ __forceinline__ void operator()(const f32x4 (&acc)[2][2][4][2], const Unit& u, int wr, int wc, int fr, int fq, int) const {
        const int row0 = u.pm * BM + wr * 64 + fr, col0 = u.pn * BM + wc * 32 + 8 * fq;
        const float* gb = gvec + (size_t)((u.pm * BM) / SEQ) * (6 * D);
        f32x4 gv[2][2];
#pragma unroll
        for (int bj = 0; bj < 2; ++bj)
#pragma unroll
            for (int n = 0; n < 2; ++n) gv[bj][n] = *(const f32x4*)(gb + col0 + bj * HALF + 4 * n) * wsc;
#pragma unroll
        for (int ai = 0; ai < 2; ++ai)
#pragma unroll
            for (int m = 0; m < 4; ++m) { const size_t off = (size_t)(row0 + ai * HALF + m * 16) * D + col0;
                f32x4 x0[2], x1[2];
#pragma unroll
                for (int bj = 0; bj < 2; ++bj) {
                    if constexpr (IN_F32) { x0[bj] = *(const f32x4*)((const float*)xin + off + bj * HALF); x1[bj] = *(const f32x4*)((const float*)xin + off + bj * HALF + 4); }
                    else { const u32x4 w = *(const u32x4*)((const bf16_t*)xin + off + bj * HALF);
                        x0[bj] = (f32x4){__uint_as_float(w.x << 16), __uint_as_float(w.x & 0xffff0000u), __uint_as_float(w.y << 16), __uint_as_float(w.y & 0xffff0000u)};
                        x1[bj] = (f32x4){__uint_as_float(w.z << 16), __uint_as_float(w.z & 0xffff0000u), __uint_as_float(w.w << 16), __uint_as_float(w.w & 0xffff0000u)}; } }
#pragma unroll
                for (int bj = 0; bj < 2; ++bj) { const f32x4 v0 = x0[bj] + gv[bj][0] * acc[ai][bj][m][0], v1 = x1[bj] + gv[bj][1] * acc[ai][bj][m][1];
                    u32x4 w; w.x = cvt_pk_bf16(v0[0], v0[1]); w.y = cvt_pk_bf16(v0[2], v0[3]); w.z = cvt_pk_bf16(v1[0], v1[1]); w.w = cvt_pk_bf16(v1[2], v1[3]);
                    *(u32x4*)(xout + off + bj * HALF) = w; } }
    }
};
struct EpiGateUp {
    static constexpr bool PERM = true, WIDE = false;
    unsigned char* ACT; const PG8_LAS unsigned char* lds0; float wsc;
    __device__ __forceinline__ void operator()(const f32x4 (&acc)[2][2][4][2], const Unit& u, int wr, int wc, int fr, int fq, int ui) const {
        const int row0 = u.pm * BM + wr * 64 + fr, c0 = wc * 32 + 8 * fq, hc0 = u.pn * HALF + c0;
        f32x4 ba[2], bb[2];
        { const PG8_LAS unsigned char* bt = lds0 + (ui < 16 ? BIAS_OFF + ui * 512 : IDX_OFF + 17 * 512 + (ui - 16) * 512) + 2 * c0;
          const u32x4 wa = *(const PG8_LAS u32x4*)bt, wb = *(const PG8_LAS u32x4*)(bt + 256);
          ba[0] = (f32x4){__uint_as_float(wa.x << 16), __uint_as_float(wa.x & 0xffff0000u), __uint_as_float(wa.y << 16), __uint_as_float(wa.y & 0xffff0000u)};
          ba[1] = (f32x4){__uint_as_float(wa.z << 16), __uint_as_float(wa.z & 0xffff0000u), __uint_as_float(wa.w << 16), __uint_as_float(wa.w & 0xffff0000u)};
          bb[0] = (f32x4){__uint_as_float(wb.x << 16), __uint_as_float(wb.x & 0xffff0000u), __uint_as_float(wb.y << 16), __uint_as_float(wb.y & 0xffff0000u)};
          bb[1] = (f32x4){__uint_as_float(wb.z << 16), __uint_as_float(wb.z & 0xffff0000u), __uint_as_float(wb.w << 16), __uint_as_float(wb.w & 0xffff0000u)}; }
#pragma unroll
        for (int ai = 0; ai < 2; ++ai)
#pragma unroll
            for (int m = 0; m < 4; ++m) { float o[8];
#pragma unroll
                for (int n = 0; n < 2; ++n)
#pragma unroll
                    for (int h = 0; h < 2; ++h) {
                        f32x2 a = (f32x2){acc[ai][0][m][n][2 * h], acc[ai][0][m][n][2 * h + 1]} * wsc + (f32x2){ba[n][2 * h], ba[n][2 * h + 1]};
                        f32x2 b = (f32x2){acc[ai][1][m][n][2 * h], acc[ai][1][m][n][2 * h + 1]} * wsc + (f32x2){bb[n][2 * h], bb[n][2 * h + 1]};
                        a.x = fminf(a.x, 7.0f); a.y = fminf(a.y, 7.0f);
                        b.x = __builtin_amdgcn_fmed3f(b.x, -7.0f, 7.0f); b.y = __builtin_amdgcn_fmed3f(b.y, -7.0f, 7.0f);
                        const f32x2 t = a * -2.45546696f;
                        const f32x2 d = (f32x2){__builtin_amdgcn_exp2f(t.x), __builtin_amdgcn_exp2f(t.y)} + 1.0f;
                        const f32x2 r = (f32x2){__builtin_amdgcn_rcpf(d.x), __builtin_amdgcn_rcpf(d.y)};
                        const f32x2 res = (a * r) * (b + 1.0f);
                        o[4 * n + 2 * h] = res.x; o[4 * n + 2 * h + 1] = res.y; }
                *(u32x2*)(ACT + (size_t)(row0 + ai * HALF + m * 16) * D + hc0) = pack8_fp8(o); }
    }
};
struct EpiDown {
    static constexpr bool PERM = true, WIDE = true;
    unsigned char* SLOT; const PG8_LAS unsigned char* lds0;
    const PG8_LAS int* slot_tab;
    float wsc;
    __device__ __forceinline__ void operator()(const f32x4 (&acc)[2][2][4][2], const Unit& u, int wr, int wc, int fr, int fq, int ui) const {
        const int c0 = wc * 64 + 16 * fq, col0 = u.pn * BM + c0;
        const PG8_LAS int* st = slot_tab + ui * BM + wr * 64 + fr;
        f32x4 bv[2][2];
#pragma unroll
        for (int bj = 0; bj < 2; ++bj) { const u32x4 w = *(const PG8_LAS u32x4*)(lds0 + BIAS_OFF + ui * 512 + 2 * (c0 + 8 * bj));
            bv[bj][0] = (f32x4){__uint_as_float(w.x << 16), __uint_as_float(w.x & 0xffff0000u), __uint_as_float(w.y << 16), __uint_as_float(w.y & 0xffff0000u)};
            bv[bj][1] = (f32x4){__uint_as_float(w.z << 16), __uint_as_float(w.z & 0xffff0000u), __uint_as_float(w.w << 16), __uint_as_float(w.w & 0xffff0000u)}; }
#pragma unroll
        for (int ai = 0; ai < 2; ++ai)
#pragma unroll
            for (int m = 0; m < 4; ++m) { const int slot = st[ai * HALF + m * 16];
                if (slot >= 0) { u32x4 w4;
#pragma unroll
                    for (int bj = 0; bj < 2; ++bj) { const f32x4 v0 = acc[ai][bj][m][0] * wsc + bv[bj][0], v1 = acc[ai][bj][m][1] * wsc + bv[bj][1];
                        const float o[8] = {v0[0], v0[1], v0[2], v0[3], v1[0], v1[1], v1[2], v1[3]}; const u32x2 pk = pack8_fp8(o);
                        if (bj == 0) { w4.x = pk.x; w4.y = pk.y; } else { w4.z = pk.x; w4.w = pk.y; } }
                    *(u32x4*)(SLOT + (size_t)slot * D + col0) = w4; } }
    }
};

template <class Epi, class Sched, bool GATHER = false, bool FP8 = false, bool ALIGN_EPI = true>
__device__ __forceinline__ void gemm_phase(PG8_LAS unsigned char* lds, const Gemm g, const Sched& S, const Epi& E, const int tid, const PG8_LAS unsigned short* idx = nullptr) {
    const int wid = __builtin_amdgcn_readfirstlane(tid >> 6), lane = tid & 63, wr = wid >> 2, wc = wid & 3, fr = lane & 15, fq = lane >> 4;
    const int K = g.K, nt = K / BK;
    unsigned voffB[2]; int Ra[2], Ca[2];
#pragma unroll
    for (int i = 0; i < 2; ++i) { int R, C; stage_rc(tid * 16 + i * 8192, R, C);
        const int Rb = Epi::WIDE ? (64 * (R >> 5) + 16 * ((R & 15) >> 2) + 4 * ((R >> 4) & 1) + (R & 3)) : (Epi::PERM ? ((R & ~31) + perm32(R & 31)) : R);
        Ra[i] = R; Ca[i] = C; voffB[i] = (unsigned)(Rb * K + C) * 2u; }
    const size_t bhs = Epi::WIDE ? (size_t)8 * K * 2 : (size_t)HALF * K * 2;
    const size_t kstep = (size_t)(BK * 2);
    const size_t hstep = (size_t)HALF * K * 2;
    const size_t tstep = 2 * hstep;
    const unsigned ldsw = (unsigned)wid * 1024u;
    const int aoff = lds_byte(wr * 64 + fr, fq * 8), boff = lds_byte(wc * 32 + fr, fq * 8);
#define PG8_SA(b, h) (((b) * 2 + (h)) * HTB)
#define PG8_SB(b, h) ((4 + (b) * 2 + (h)) * HTB)
#define PG8_STAGE(bufoff, gbase, voff) do { _Pragma("unroll") for (int _i = 0; _i < 2; ++_i) \
        __builtin_amdgcn_global_load_lds((const unsigned*)((const char*)(gbase) + (voff)[_i]), (PG8_LAS unsigned*)(lds + (bufoff) + ldsw + _i * 8192), 16, 0, 0); } while (0)
#define PG8_LDA(dst, b, h) do { _Pragma("unroll") for (int m = 0; m < 4; ++m) _Pragma("unroll") for (int k = 0; k < 2; ++k) dst[m][k] = *(const PG8_LAS bf16x8*)(lds + PG8_SA(b, h) + aoff + m * 2048 + k * 1024); } while (0)
#define PG8_LDB(dst, b, h) do { _Pragma("unroll") for (int n = 0; n < 2; ++n) _Pragma("unroll") for (int k = 0; k < 2; ++k) dst[n][k] = *(const PG8_LAS bf16x8*)(lds + PG8_SB(b, h) + boff + n * 2048 + k * 1024); } while (0)
#define PG8_MMA(ai, bj, At, Bt) do { __builtin_amdgcn_s_setprio(1); _Pragma("unroll") for (int m = 0; m < 4; ++m) _Pragma("unroll") for (int n = 0; n < 2; ++n) { \
        if constexpr (FP8) { typedef int v4i_ __attribute__((ext_vector_type(4))); typedef int v8i_ __attribute__((ext_vector_type(8))); \
            const v8i_ wa = __builtin_shufflevector(__builtin_bit_cast(v4i_, Bt[n][0]), __builtin_bit_cast(v4i_, Bt[n][1]), 0, 1, 2, 3, 4, 5, 6, 7); \
            const v8i_ xa = __builtin_shufflevector(__builtin_bit_cast(v4i_, At[m][0]), __builtin_bit_cast(v4i_, At[m][1]), 0, 1, 2, 3, 4, 5, 6, 7); \
            acc[ai][bj][m][n] = __builtin_amdgcn_mfma_scale_f32_16x16x128_f8f6f4(wa, xa, acc[ai][bj][m][n], 0, 0, 0, 0x7f7f7f7f, 0, 0x7f7f7f7f); } \
        else { _Pragma("unroll") for (int k = 0; k < 2; ++k) acc[ai][bj][m][n] = __builtin_amdgcn_mfma_f32_16x16x32_bf16(Bt[n][k], At[m][k], acc[ai][bj][m][n], 0, 0, 0); } } \
        __builtin_amdgcn_s_setprio(0); } while (0)
#define PG8_WAIT_V(n) asm volatile("s_waitcnt vmcnt(" #n ")" ::: "memory")
#define PG8_WAIT_L(n) asm volatile("s_waitcnt lgkmcnt(" #n ")" ::: "memory")
#define PG8_BAR __builtin_amdgcn_s_barrier()
#define PG8_SCHED __builtin_amdgcn_sched_barrier(0)
#define PG8_AOFFS(dst, ui_, pm_) do { _Pragma("unroll") for (int _h = 0; _h < 2; ++_h) _Pragma("unroll") for (int _i = 0; _i < 2; ++_i) { \
        if constexpr (GATHER) dst[_h][_i] = (idx ? (unsigned)idx[(ui_) * BM + _h * HALF + Ra[_i]] : (unsigned)((pm_) * BM + _h * HALF + Ra[_i])) * (unsigned)(K * 2) + (unsigned)(Ca[_i] * 2); \
        else dst[_h][_i] = (unsigned)((_h * HALF + Ra[_i]) * K + Ca[_i]) * 2u; } } while (0)
    Unit cur, nxt; int ui = 0;
    if (!S.next(0, cur)) return;
    f32x4 acc[2][2][4][2];
#pragma unroll
    for (int a = 0; a < 2; ++a)
#pragma unroll
        for (int b = 0; b < 2; ++b)
#pragma unroll
            for (int m = 0; m < 4; ++m)
#pragma unroll
                for (int n = 0; n < 2; ++n) acc[a][b][m][n] = (f32x4){0.f, 0.f, 0.f, 0.f};
    bf16x8 At[4][2], B0[2][2], B1[2][2];
    unsigned offA[2][2];
    PG8_AOFFS(offA, 0, cur.pm);
    const char* cA = GATHER ? (const char*)g.A : (const char*)g.A + (size_t)cur.pm * tstep;
    const char* cB = (const char*)g.Bt + (size_t)cur.e * g.bgstride + (size_t)cur.pn * tstep;
    PG8_STAGE(PG8_SB(0, 0), cB, voffB); PG8_STAGE(PG8_SB(0, 1), cB + bhs, voffB); PG8_STAGE(PG8_SA(0, 0), cA, offA[0]); PG8_STAGE(PG8_SA(0, 1), cA, offA[1]);
    if (wr == 1) PG8_BAR;
    PG8_WAIT_V(2); PG8_BAR;
    PG8_STAGE(PG8_SB(1, 0), cB + kstep, voffB); PG8_STAGE(PG8_SA(1, 0), cA + kstep, offA[0]); PG8_STAGE(PG8_SB(1, 1), cB + bhs + kstep, voffB);
    PG8_WAIT_V(6); PG8_BAR;
    for (;;) {
        const bool has_next = S.next(ui + 1, nxt);
        const char* nA = GATHER ? (const char*)g.A : (has_next ? (const char*)g.A + (size_t)nxt.pm * tstep : cA);
        const char* nB = has_next ? (const char*)g.Bt + (size_t)nxt.e * g.bgstride + (size_t)nxt.pn * tstep : cB;
        for (int t = 0; t < nt; t += 2) {
            const bool last = (t == nt - 2);
            const char* a1 = cA + (size_t)(t + 1) * kstep;
            const char* a2 = last ? nA : cA + (size_t)(t + 2) * kstep; const char* b2 = last ? nB : cB + (size_t)(t + 2) * kstep;
            const char* a3 = a2 + kstep; const char* b3 = b2 + kstep;
            PG8_LDB(B0, 0, 0); PG8_LDB(B1, 0, 1); PG8_SCHED; PG8_LDA(At, 0, 0); PG8_STAGE(PG8_SA(1, 1), a1, offA[1]);
            if constexpr (GATHER) { if (last && has_next) PG8_AOFFS(offA, ui + 1, nxt.pm); }
            PG8_WAIT_V(8); PG8_WAIT_L(0); PG8_BAR; PG8_MMA(0, 0, At, B0); PG8_MMA(0, 1, At, B1); PG8_BAR; PG8_SCHED;
            PG8_LDA(At, 0, 1); PG8_STAGE(PG8_SB(0, 0), b2, voffB); PG8_STAGE(PG8_SB(0, 1), b2 + bhs, voffB); PG8_STAGE(PG8_SA(0, 0), a2, offA[0]);
            PG8_WAIT_V(8); PG8_WAIT_L(0); PG8_BAR; PG8_MMA(1, 0, At, B0); PG8_MMA(1, 1, At, B1); PG8_BAR; PG8_SCHED;
            PG8_LDB(B0, 1, 0); PG8_LDB(B1, 1, 1); PG8_SCHED; PG8_LDA(At, 1, 0); PG8_STAGE(PG8_SA(0, 1), a2, offA[1]);
            PG8_WAIT_V(8); PG8_WAIT_L(0); PG8_BAR; PG8_MMA(0, 0, At, B0); PG8_MMA(0, 1, At, B1); PG8_BAR; PG8_SCHED;
            PG8_LDA(At, 1, 1); PG8_STAGE(PG8_SB(1, 0), b3, voffB); PG8_STAGE(PG8_SB(1, 1), b3 + bhs, voffB); PG8_STAGE(PG8_SA(1, 0), a3, offA[0]);
            PG8_WAIT_V(8); PG8_WAIT_L(0); PG8_BAR; PG8_MMA(1, 0, At, B0); PG8_MMA(1, 1, At, B1); PG8_BAR; PG8_SCHED;
        }
        if constexpr (ALIGN_EPI) { if (wr == 0) PG8_BAR; }
        E(acc, cur, wr, wc, fr, fq, ui);
        if (!has_next) break;
#pragma unroll
        for (int a = 0; a < 2; ++a)
#pragma unroll
            for (int b = 0; b < 2; ++b)
#pragma unroll
                for (int m = 0; m < 4; ++m)
#pragma unroll
                    for (int n = 0; n < 2; ++n) acc[a][b][m][n] = (f32x4){0.f, 0.f, 0.f, 0.f};
        cur = nxt; cA = nA; cB = nB; ++ui;
        if constexpr (ALIGN_EPI) { if (wr == 1) PG8_BAR; }
    }
    PG8_WAIT_V(0);
    if constexpr (!ALIGN_EPI) { if (wr == 0) PG8_BAR; }
    PG8_BAR;
#undef PG8_SA
#undef PG8_SB
#undef PG8_STAGE
#undef PG8_LDA
#undef PG8_LDB
#undef PG8_MMA
#undef PG8_WAIT_V
#undef PG8_WAIT_L
#undef PG8_BAR
#undef PG8_SCHED
#undef PG8_AOFFS
}
}

#define XB_TMO      128
#define XB_XCNT(j)  (256  + 64 * (j))
#define XB_XSUB(j)  (1280 + 64 * (j))
#define XB_XGEN(j)  (2304 + 64 * (j))
#define XB_TOP      3328
#define XB_TOPGEN   3392
#define XCD_BAR_WORDS 3456
#define XB_SPIN_CAP (1u << 21)

__device__ __forceinline__ unsigned xb_ld(unsigned* p)              { return __hip_atomic_load(p, __ATOMIC_RELAXED, __HIP_MEMORY_SCOPE_AGENT); }
__device__ __forceinline__ unsigned xb_add(unsigned* p, unsigned v) { return __hip_atomic_fetch_add(p, v, __ATOMIC_RELAXED, __HIP_MEMORY_SCOPE_AGENT); }
__device__ __forceinline__ unsigned xb_xcc_id() { return (unsigned)__builtin_amdgcn_s_getreg((3 << 11) | 20) & 0xFu; }
#define XB_SPIN(cond, bar) do { unsigned _sp = 0; while (cond) { __builtin_amdgcn_s_sleep(1); \
    if ((++_sp & 255u) == 0u) { if (xb_ld(&(bar)[XB_TMO])) break; if (_sp > XB_SPIN_CAP) { atomicAdd(&(bar)[XB_TMO], 1u); break; } } } } while (0)

struct XcdBarrier { unsigned* bar; unsigned x; volatile LAS unsigned* st; };

__device__ __forceinline__ XcdBarrier xcd_barrier_post(unsigned* bar, volatile LAS unsigned* st) {
    XcdBarrier b; b.bar = bar; b.x = xb_xcc_id(); b.st = st;
    if (threadIdx.x == 0) (void)xb_add(&bar[XB_XCNT(b.x)], 1u);
    return b;
}
__device__ __forceinline__ void xcd_barrier_complete(unsigned* bar, unsigned x, unsigned& nloc, unsigned& nx) {
    const unsigned G = gridDim.x * gridDim.y * gridDim.z;
    unsigned sum, cnt, mine, sp = 0u;
    for (;;) {
        sum = 0u; cnt = 0u; mine = 0u;
#pragma unroll
        for (unsigned j = 0; j < 16; ++j) { const unsigned c = xb_ld(&bar[XB_XCNT(j)]); sum += c; cnt += (c > 0u) ? 1u : 0u; mine = (j == x) ? c : mine; }
        if (sum == G) break;
        __builtin_amdgcn_s_sleep(1);
        if ((++sp & 255u) == 0u) { if (xb_ld(&bar[XB_TMO])) break; if (sp > XB_SPIN_CAP) { atomicAdd(&bar[XB_TMO], 1u); break; } }
    }
    nloc = mine > 0u ? mine : 1u; nx = cnt > 0u ? cnt : 1u;
}
__device__ __forceinline__ void xcd_barrier(const XcdBarrier& b) {
    asm volatile("s_waitcnt vmcnt(0)" ::: "memory");
    __syncthreads();
    if (threadIdx.x == 0) {
        unsigned* bar = b.bar;
        __builtin_amdgcn_s_waitcnt(0);
        unsigned nloc = b.st[0], nx = b.st[1];
        if (nloc == 0u) { xcd_barrier_complete(bar, b.x, nloc, nx); b.st[0] = nloc; b.st[1] = nx; }
        const unsigned old = xb_add(&bar[XB_XSUB(b.x)], 1u);
        const unsigned gen = old / nloc;
        if (old + 1u == (gen + 1u) * nloc) {
            __builtin_amdgcn_fence(__ATOMIC_RELEASE, "agent");
            asm volatile("s_waitcnt vmcnt(0)" ::: "memory");
            const unsigned og = xb_add(&bar[XB_TOP], 1u);
            const unsigned tg = og / nx;
            if (og + 1u == (tg + 1u) * nx) xb_add(&bar[XB_TOPGEN], 1u);
            else XB_SPIN(xb_ld(&bar[XB_TOPGEN]) == tg, bar);
            __builtin_amdgcn_fence(__ATOMIC_ACQUIRE, "agent");
            xb_add(&bar[XB_XGEN(b.x)], 1u);
            asm volatile("s_waitcnt vmcnt(0)" ::: "memory");
        } else {
            XB_SPIN(xb_ld(&bar[XB_XGEN(b.x)]) == gen, bar);
            __builtin_amdgcn_fence(__ATOMIC_ACQUIRE, "agent");
            asm volatile("s_waitcnt vmcnt(0)" ::: "memory");
        }
    }
    __syncthreads();
}

struct Params {
    const float* x; const float* c; const float* w_ada; const float* b_ada; const float* norm1_g; const float* norm2_g; const float* w_in; const float* conv_w;
    const float* conv_norm_g; const float* lower_bounds; const float* hgrn_norm_g; const float* w_out; const float* w_router; const float* b_router;
    const float* w_gu; const float* b_gu; const float* w_down; const float* b_down; const float* final_g;
    float* out; unsigned char* ws;
    int ph_lo, ph_hi;
};

struct Ctx {
    LAS unsigned char* lds; int tid, lane, wave, G, gw, NGW, bid;
};
__device__ __forceinline__ Ctx make_ctx(LAS unsigned char* lds) {
    Ctx cx; int tid = threadIdx.x; asm volatile("" : "+v"(tid)); int bid = blockIdx.x; asm volatile("" : "+s"(bid)); int G = gridDim.x; asm volatile("" : "+s"(G));
    cx.lds = lds; cx.tid = tid; cx.lane = tid & 63; cx.wave = __builtin_amdgcn_readfirstlane(tid >> 6); cx.G = G; cx.gw = bid * 8 + cx.wave; cx.NGW = G * 8; cx.bid = bid;
    return cx;
}
__device__ __forceinline__ unsigned char* launder(unsigned char* q) { GAS unsigned char* g = (GAS unsigned char*)q; asm volatile("" : "+s"(g)); return (unsigned char*)g; }

__device__ __forceinline__ void transpose_item(const float* W, int N, bf16_t* WT, int k0, int n0, int wt_row0, LAS float* scr, int lane) {
    { float v[64];
#pragma unroll
      for (int i = 0; i < 64; ++i) v[i] = W[(size_t)(k0 + i) * N + n0 + lane];
#pragma unroll
      for (int i = 0; i < 64; ++i) scr[i * 65 + lane] = v[i]; }
    LDS_WAIT();
    const int c = lane & 7;
#pragma unroll
    for (int j = 0; j < 8; ++j) { const int n = (lane >> 3) + 8 * j; const LAS float* s = scr + (8 * c) * 65 + n;
        u32x4 o; o.x = pk2(s[0], s[65]); o.y = pk2(s[130], s[195]); o.z = pk2(s[260], s[325]); o.w = pk2(s[390], s[455]);
        *(u32x4*)(WT + (size_t)(wt_row0 + n) * D + k0 + 8 * c) = o; }
    LDS_WAIT();
}
__device__ __forceinline__ void transpose_item_fp8(const float* W, int N, unsigned char* WT, int k0, int n0, int wt_row0, float scale, LAS float* scr, int lane) {
    const int kq = lane >> 4, nq = lane & 15;
    f32x4 ld[16];
#pragma unroll
    for (int i = 0; i < 16; ++i) ld[i] = __builtin_nontemporal_load((const f32x4*)(W + (size_t)(k0 + 4 * i + kq) * N + n0 + 4 * nq));
#pragma unroll
    for (int i = 0; i < 16; ++i) *(LAS f32x4*)(scr + (4 * i + kq) * 68 + 4 * nq) = ld[i];
    LDS_WAIT();
    float v[64];
#pragma unroll
    for (int i = 0; i < 64; ++i) v[i] = scr[i * 68 + lane];
    LDS_WAIT();
    LAS unsigned char* sb = (LAS unsigned char*)scr;
#pragma unroll
    for (int q = 0; q < 4; ++q) { float o0[8], o1[8];
#pragma unroll
        for (int i = 0; i < 8; ++i) { o0[i] = v[16 * q + i] * scale; o1[i] = v[16 * q + 8 + i] * scale; }
        const u32x2 a = pack8_fp8(o0), c = pack8_fp8(o1);
        *(LAS u32x4*)(sb + lane * 80 + 16 * q) = (u32x4){a.x, a.y, c.x, c.y}; }
    LDS_WAIT();
#pragma unroll
    for (int i = 0; i < 4; ++i) { const int row = (lane >> 2) + 16 * i, pc = lane & 3;
        const u32x4 w = *(const LAS u32x4*)(sb + row * 80 + 16 * pc);
        *(u32x4*)(WT + (size_t)(wt_row0 + row) * D + k0 + 16 * pc) = w; }
    LDS_WAIT();
}
__device__ __forceinline__ void convert_item(const Params& p, unsigned char* ws, int l, int which, int it, LAS float* scr, int lane) {
    constexpr int I_GU = 16 * 32, I_DN = 16 * 16;
    if (which == 0) { const int mtx = l * NE + it / I_GU, q = it % I_GU, nb = q % 32, kb = q / 32; const int n0 = nb * 64;
        const int row0 = (n0 < 1024) ? (256 * (n0 >> 7) + (n0 & 127)) : (256 * ((n0 - 1024) >> 7) + 128 + ((n0 - 1024) & 127));
        transpose_item_fp8(p.w_gu + (size_t)mtx * D * 2048, 2048, (unsigned char*)(ws + WS_WGU) + (size_t)mtx * 2048 * D, kb * 64, n0, row0, WGU_SCALE, scr, lane);
    } else { const int mtx = l * NE + it / I_DN, q = it % I_DN, nb = q % 16, kb = q / 16;
        transpose_item_fp8(p.w_down + (size_t)mtx * D * D, D, (unsigned char*)(ws + WS_WDN) + (size_t)mtx * D * D, kb * 64, nb * 64, nb * 64, WGU_SCALE, scr, lane); }
}
constexpr int CONV_DELTA = 4;
constexpr int CONV_TOT_GU = NE * 16 * 32, CONV_TOT_DN = NE * 16 * 16;
constexpr int CONV_STAT_GU = CONV_TOT_GU * 3 / 4, CONV_STAT_DN = CONV_TOT_DN * 3 / 4;
__device__ __forceinline__ void convert_expert_weights(const Params& p, const Ctx& cx, unsigned char* ws, int l, int which, int r_hi = 0) {
    LAS float* scr = (LAS float*)(cx.lds + cx.wave * 17408);
    if (which == 0) {
        for (int it = cx.gw; it < CONV_STAT_GU; it += cx.NGW) convert_item(p, ws, l, 0, it, scr, cx.lane);
    } else {
        const int wlo = cx.G - r_hi; int rhi = (CONV_STAT_DN - CONV_DELTA * wlo * 8 + cx.NGW / 2) / cx.NGW; rhi = rhi < 0 ? 0 : rhi;
        for (int j = 0;; ++j) { int it;
            if (j < rhi) it = j * cx.NGW + cx.gw; else { if (cx.bid < r_hi) break; it = rhi * cx.NGW + (j - rhi) * wlo * 8 + (cx.bid - r_hi) * 8 + cx.wave; }
            if (it >= CONV_STAT_DN) break;
            convert_item(p, ws, l, 1, it, scr, cx.lane); }
    }
    __syncthreads();
}
__device__ __forceinline__ void convert_tail(const Params& p, const Ctx& cx, unsigned char* ws, int l, int which) {
    LAS float* scr = (LAS float*)(cx.lds + cx.wave * 17408);
    volatile LAS int* tick = (volatile LAS int*)(cx.lds + MISC_OFF + MS_BAR + 32);
    unsigned* q = (unsigned*)(ws + WS_CTL) + CW_QUEUE + 64 * (2 * l + which);
    const int first = which == 0 ? CONV_STAT_GU : CONV_STAT_DN, total = which == 0 ? CONV_TOT_GU : CONV_TOT_DN;
    if (cx.tid == 0) tick[0] = (int)__hip_atomic_fetch_add(q, 8u, __ATOMIC_RELAXED, __HIP_MEMORY_SCOPE_AGENT);
    __syncthreads();
    int t = tick[0], par = 0;
    while (first + t < total) {
        int nt = 0;
        if (cx.tid == 0) nt = (int)__hip_atomic_fetch_add(q, 8u, __ATOMIC_RELAXED, __HIP_MEMORY_SCOPE_AGENT);
        const int it = first + t + cx.wave;
        if (it < total) convert_item(p, ws, l, which, it, scr, cx.lane);
        par ^= 1;
        if (cx.tid == 0) tick[par] = nt;
        __syncthreads();
        t = tick[par];
    }
    __syncthreads();
}
__device__ __forceinline__ void phase_prologue(const Params& p, LAS unsigned char* ldsb) {
    const Ctx cx = make_ctx(ldsb);
    unsigned char* ws = launder(p.ws);
    LAS float* scr = (LAS float*)(cx.lds + cx.wave * 17408);
    constexpr int I_IN = 16 * (NPROJ / 64), I_OUT = 16 * 16;
    constexpr int T_IN = DEPTH * I_IN, T_OUT = DEPTH * I_OUT;
    for (int it = cx.gw; it < T_IN + T_OUT; it += cx.NGW) {
        int r = it;
        if (r < T_IN) { const int mtx = r / I_IN, q = r % I_IN, nb = q % (NPROJ / 64), kb = q / (NPROJ / 64);
            transpose_item(p.w_in + (size_t)mtx * D * NPROJ, NPROJ, (bf16_t*)(ws + WS_WIN) + (size_t)mtx * NPROJ * D, kb * 64, nb * 64, win_row(nb * 64), scr, cx.lane); continue; }
        r -= T_IN;
        { const int mtx = r / I_OUT, q = r % I_OUT, nb = q % 16, kb = q / 16;
            transpose_item_fp8(p.w_out + (size_t)mtx * D * D, D, (unsigned char*)(ws + WS_WOUT) + (size_t)mtx * D * D, kb * 64, nb * 64, nb * 64, WGU_SCALE, scr, cx.lane); }
    }
    __syncthreads();
    {
        LAS float* cact = (LAS float*)(cx.lds);
        LAS float* part = (LAS float*)(cx.lds + 8192);
        bool have = false;
        for (int item = cx.bid; item < DEPTH * 48; item += cx.G) {
            if (!have) { for (int i = cx.tid; i < 2 * D; i += 512) { const float v = p.c[i]; cact[i] = v / (1.0f + __expf(-v)); } have = true; __syncthreads(); }
            const int l = item / 48, col0 = (item % 48) * 128;
            const float* wp = p.w_ada + ((size_t)l * D + cx.wave * 128) * (6 * D) + col0 + 2 * cx.lane;
            float a00 = 0.f, a01 = 0.f, a10 = 0.f, a11 = 0.f;
#pragma unroll 8
            for (int kk = 0; kk < 128; ++kk) { const f32x2 wv = __builtin_nontemporal_load((const f32x2*)(wp + (size_t)kk * (6 * D))); const float c0 = cact[cx.wave * 128 + kk], c1 = cact[D + cx.wave * 128 + kk];
                a00 += c0 * wv.x; a01 += c0 * wv.y; a10 += c1 * wv.x; a11 += c1 * wv.y; }
            part[(cx.wave * 2 + 0) * 128 + 2 * cx.lane] = a00; part[(cx.wave * 2 + 0) * 128 + 2 * cx.lane + 1] = a01;
            part[(cx.wave * 2 + 1) * 128 + 2 * cx.lane] = a10; part[(cx.wave * 2 + 1) * 128 + 2 * cx.lane + 1] = a11;
            __syncthreads();
            if (cx.tid < 256) { const int b = cx.tid >> 7, col = cx.tid & 127; float s = p.b_ada[(size_t)l * 6 * D + col0 + col];
#pragma unroll
                for (int w = 0; w < 8; ++w) s += part[(w * 2 + b) * 128 + col];
                ((float*)(ws + WS_ADA))[((size_t)l * 2 + b) * (6 * D) + col0 + col] = s; }
            __syncthreads();
        }
    }
    if (cx.bid == cx.G - 1) {
        const int ch = cx.tid;
        float v[DEPTH], m = -3.0e38f;
#pragma unroll
        for (int l = 0; l < DEPTH; ++l) { v[l] = p.lower_bounds[l * 512 + ch]; m = fmaxf(m, v[l]); }
        float s = 0.f;
#pragma unroll
        for (int l = 0; l < DEPTH; ++l) { v[l] = __expf(v[l] - m); s += v[l]; }
        float run = 0.f; float* LB = (float*)(ws + WS_LB);
        LB[ch] = 0.f;
#pragma unroll
        for (int l = 1; l < DEPTH; ++l) { run += v[l] / s; LB[l * 512 + ch] = run; }
    }
}

__device__ __forceinline__ void norm_mod_store(const f32x4 (&v)[4], const float* gnorm, const float* shift, const float* scale, bf16_t* orow, int lane) {
    float ss = 0.f;
#pragma unroll
    for (int j = 0; j < 4; ++j) ss += (v[j].x * v[j].x + v[j].y * v[j].y) + (v[j].z * v[j].z + v[j].w * v[j].w);
    const float rstd = frsq(wave_sum(ss) * (1.0f / D) + RMS_EPS);
#pragma unroll
    for (int j = 0; j < 4; ++j) { const int c = 4 * lane + 256 * j;
        const f32x4 g = *(const f32x4*)(gnorm + c), sh = *(const f32x4*)(shift + c), sc = *(const f32x4*)(scale + c);
        const f32x4 y = (v[j] * rstd) * g * (sc + 1.0f) + sh;
        u32x2 w; w.x = pk2(y.x, y.y); w.y = pk2(y.z, y.w);
        *(u32x2*)(orow + c) = w; }
}
__device__ __forceinline__ void norm_mod_store8(const float (&v)[2][8], const float* gnorm, const float* shift, const float* scale, bf16_t* orow, int lane) {
    float ss = 0.f;
#pragma unroll
    for (int j = 0; j < 2; ++j)
#pragma unroll
        for (int i = 0; i < 8; ++i) ss += v[j][i] * v[j][i];
    const float rstd = frsq(wave_sum(ss) * (1.0f / D) + RMS_EPS);
#pragma unroll
    for (int j = 0; j < 2; ++j) { const int c = 8 * lane + 512 * j; float o[8];
#pragma unroll
        for (int h = 0; h < 2; ++h) { const f32x4 g = *(const f32x4*)(gnorm + c + 4 * h), sh = *(const f32x4*)(shift + c + 4 * h), sc = *(const f32x4*)(scale + c + 4 * h);
#pragma unroll
            for (int i = 0; i < 4; ++i) o[4 * h + i] = (v[j][4 * h + i] * rstd) * g[i] * (sc[i] + 1.0f) + sh[i]; }
        *(u32x4*)(orow + c) = pack8(o); }
}
__device__ __forceinline__ void phase_norm1_first(const Params& p, LAS unsigned char* ldsb) {
    const Ctx cx = make_ctx(ldsb);
    unsigned char* ws = launder(p.ws);
    const float* ada = (const float*)(ws + WS_ADA);
    bf16_t* HN = (bf16_t*)(ws + WS_HN);
    for (int row = cx.gw; row < NTOK; row += cx.NGW) {
        const int b = row / SEQ; f32x4 v[4];
#pragma unroll
        for (int j = 0; j < 4; ++j) v[j] = __builtin_nontemporal_load((const f32x4*)(p.x + (size_t)row * D + 4 * cx.lane + 256 * j));
        norm_mod_store(v, p.norm1_g, ada + (size_t)b * 6 * D + 0 * D, ada + (size_t)b * 6 * D + 1 * D, HN + (size_t)row * D, cx.lane);
    }
    if (cx.bid == cx.G - 1 && cx.tid < 64) ((u32x4*)(ws + WS_HN8 + (size_t)NTOK * D))[cx.tid] = (u32x4){0u, 0u, 0u, 0u};
    { u32x4* WLG = (u32x4*)(ws + WS_WL);
      for (int idx = cx.bid * 512 + cx.tid; idx < DEPTH * 2 * 4096; idx += cx.G * 512) { const int lb2 = idx >> 12, f = idx & 4095, l = lb2 >> 1, b = lb2 & 1;
          const int sk = f >> 7, nt = (f >> 6) & 1, ln = f & 63, gg = ln >> 4, c = ln & 15, k0 = 32 * sk + 8 * gg, e = 16 * nt + c;
          const float* sc = ada + ((size_t)l * 2 + b) * 6 * D + 4 * D; const float* gn = p.norm2_g + (size_t)l * D; const float* wr_l = p.w_router + (size_t)l * D * NE;
          float hi[8], lo[8];
#pragma unroll
          for (int i = 0; i < 8; ++i) { const float w = gn[k0 + i] * (1.0f + sc[k0 + i]) * wr_l[(size_t)(k0 + i) * NE + e]; const float h = __uint_as_float(f2bf(w) << 16); hi[i] = h; lo[i] = w - h; }
          u32x4* dst = WLG + (size_t)lb2 * 8192 + (size_t)((sk * 2 + nt) * 2) * 64 + ln;
          dst[0] = pack8(hi); dst[64] = pack8(lo); } }
    for (int item = cx.bid; item < DEPTH * 2; item += cx.G) {
        const int l = item >> 1, b = item & 1; LAS float* part = (LAS float*)cx.lds;
        const float* sh = ada + ((size_t)l * 2 + b) * 6 * D + 3 * D; const float* wr_l = p.w_router + (size_t)l * D * NE;
        const int e = cx.tid & 31, pt = cx.tid >> 5; float s = 0.f;
        for (int k = pt * 64; k < pt * 64 + 64; ++k) s += sh[k] * wr_l[(size_t)k * NE + e];
        __syncthreads(); part[pt * 32 + e] = s; __syncthreads();
        if (cx.tid < NE) { float t = p.b_router[(size_t)l * NE + cx.tid];
#pragma unroll
            for (int q = 0; q < 16; ++q) t += part[q * 32 + cx.tid];
            ((float*)(ws + WS_RB))[((size_t)l * 2 + b) * NE + cx.tid] = t; }
    }
}

__device__ __forceinline__ void hgrn_gates(const unsigned (&fw)[8]  , const f32x2 lb, LAS float* tot, int e, int lane,
                                           f32x2 (&G)[8], f32x2 (&kf)[8], f32x2 (&pre)[9]) {
    f32x2 run = (f32x2){0.f, 0.f}; const f32x2 oml = 1.0f - lb;
#pragma unroll
    for (int j = 0; j < 8; ++j) { f32x2 f = v2bf(fw[j]); f.x = fmaxf(f.x, -60.f); f.y = fmaxf(f.y, -60.f);
        const f32x2 en = v2exp2(f * (-LOG2E)), sg = v2rcp((f32x2){en.x + 1.0f, en.y + 1.0f});
        run += v2log2(lb + oml * sg);
        kf[j] = oml * en * sg;
        G[j] = run; }
    *(LAS f32x2*)(tot + e * 128 + 2 * lane) = run;
    __syncthreads();
    pre[0] = (f32x2){0.f, 0.f};
#pragma unroll
    for (int k = 0; k < 8; ++k) pre[k + 1] = pre[k] + *(const LAS f32x2*)(tot + k * 128 + 2 * lane);
    f32x2 off = (f32x2){0.f, 0.f};
#pragma unroll
    for (int k = 0; k < 8; ++k) if (k == e) off = pre[k];
#pragma unroll
    for (int j = 0; j < 8; ++j) G[j] += off;
}
__device__ __forceinline__ void load_words8_nt(unsigned (&w)[8], const bf16_t* ubase  , unsigned voff  ) {
#pragma unroll
    for (int j = 0; j < 8; ++j) w[j] = __builtin_nontemporal_load((const unsigned*)((const char*)(ubase + (size_t)j * NPO) + voff));
}
__device__ __forceinline__ void load_words8(unsigned (&w)[8], const bf16_t* ubase  , unsigned voff  ) {
#pragma unroll
    for (int j = 0; j < 8; ++j) w[j] = *(const unsigned*)((const char*)(ubase + (size_t)j * NPO) + voff);
}
__device__ __forceinline__ void pack_t8(const unsigned (&w)[8], u32x4& lo, u32x4& hi) {
    lo.x = (w[0] & 0xffffu) | (w[1] << 16); lo.y = (w[2] & 0xffffu) | (w[3] << 16); lo.z = (w[4] & 0xffffu) | (w[5] << 16); lo.w = (w[6] & 0xffffu) | (w[7] << 16);
    hi.x = (w[0] >> 16) | (w[1] & 0xffff0000u); hi.y = (w[2] >> 16) | (w[3] & 0xffff0000u); hi.z = (w[4] >> 16) | (w[5] & 0xffff0000u); hi.w = (w[6] >> 16) | (w[7] & 0xffff0000u);
}
#define MFMA16(a, b, c) __builtin_amdgcn_mfma_f32_16x16x32_bf16((a), (b), (c), 0, 0, 0)

constexpr float ST8_SCALE = 4.0f;
__device__ __forceinline__ void phase_hgrn_local(const Params& p, LAS unsigned char* ldsb, int l) {
    const Ctx cx = make_ctx(ldsb);
    unsigned char* ws = launder(p.ws);
    const bf16_t* PROJ = (const bf16_t*)(ws + WS_PROJ);
    const float* LB = (const float*)(ws + WS_LB) + l * 512;
    bf16_t* SEGS = (bf16_t*)(ws + WS_U); float* SEGD = (float*)(ws + WS_SEGD); float* DEC = (float*)(ws + WS_DEC); unsigned char* ST = (unsigned char*)(ws + WS_S);
    constexpr int KH_OFF = 0, VT_OFF = 18432, TOT_OFF = 36864, DN_OFF = 40960, RS = 144;
    LAS unsigned char* lds = cx.lds; LAS float* tot = (LAS float*)(lds + TOT_OFF); LAS float* dnl = (LAS float*)(lds + DN_OFF);
    const int e = cx.wave, lane = cx.lane, r = lane & 15, g = lane >> 4;
    constexpr int SL_OFF = 45056, SLS = 144;
#define HL_STORE_TILE(uid_) do { unsigned char* sb_ = ST + (size_t)(uid_) * (DK * DK) + 1024 * e; const unsigned lo_ = 16u * (unsigned)lane; _Pragma("unroll") for (int h2 = 0; h2 < 2; ++h2) \
        *(u32x4*)(sb_ + 8192 * h2 + lo_) = *(const LAS u32x4*)(lds + SL_OFF + 1152 * e + 64 * SLS * h2 + lo_ + 16u * ((unsigned)lane >> 3)); } while (0)
    for (int seg = cx.bid; seg < NUNIT / 8; seg += cx.G) {
        const int bh = seg >> 5, b = bh >> 2, h = bh & 3;
        const f32x2 lb = *(const f32x2*)(LB + 128 * h + 2 * lane);
        const int mb = e >> 1, nb = e & 1;
        f32x4 acc[2][4];
#pragma unroll
        for (int mi = 0; mi < 2; ++mi)
#pragma unroll
            for (int ni = 0; ni < 4; ++ni) acc[mi][ni] = (f32x4){0.f, 0.f, 0.f, 0.f};
        f32x2 cum = (f32x2){0.f, 0.f};
        asm volatile("" : "+v"(cum));
        const bf16_t* base0 = PROJ + ((size_t)b * SEQ + (size_t)(seg & 31) * 8 * CHUNK + 8 * e) * NPO + 128 * h;
        const unsigned lvo = 4u * (unsigned)lane;
        unsigned fw[8], vw[8];
        load_words8(fw, base0 + PC_F, lvo); load_words8(vw, base0 + PC_I, lvo);
        for (int j = 0; j < 8; ++j) {
            const int uid = seg * 8 + j;
            f32x2 G[8], kf[8], pre[9];
            hgrn_gates(fw, lb, tot, e, lane, G, kf, pre);
            if (j > 0) HL_STORE_TILE(uid - 1);
            { unsigned w[8];
#pragma unroll
              for (int q = 0; q < 8; ++q) w[q] = pk2v(kf[q] * v2exp2(pre[8] - G[q]));
              u32x4 lo, hi; pack_t8(w, lo, hi);
              *(LAS u32x4*)(lds + KH_OFF + (2 * lane) * RS + 16 * e) = lo; *(LAS u32x4*)(lds + KH_OFF + (2 * lane + 1) * RS + 16 * e) = hi; }
            { u32x4 lo, hi; pack_t8(vw, lo, hi);
              *(LAS u32x4*)(lds + VT_OFF + (2 * lane) * RS + 16 * e) = lo; *(LAS u32x4*)(lds + VT_OFF + (2 * lane + 1) * RS + 16 * e) = hi; }
            if (e == 0) { *(f32x2*)(DEC + (size_t)uid * DK + 2 * lane) = v2exp2(cum);
                          *(LAS f32x2*)(dnl + 2 * lane) = v2exp2(pre[8]); }
            cum += pre[8];
            if (j < 7) { const bf16_t* bn = base0 + (size_t)(j + 1) * CHUNK * NPO; load_words8(fw, bn + PC_F, lvo); load_words8(vw, bn + PC_I, lvo); }
            __syncthreads();
            {
#pragma unroll
              for (int mi = 0; mi < 2; ++mi) { const f32x4 dn = *(const LAS f32x4*)(dnl + 32 * mb + 16 * mi + 4 * g);
#pragma unroll
                  for (int ni = 0; ni < 4; ++ni) { const f32x4 a = acc[mi][ni]; const f32x4 a4 = a * ST8_SCALE;
                      int w = __builtin_amdgcn_cvt_pk_fp8_f32(a4.x, a4.y, 0, false); w = __builtin_amdgcn_cvt_pk_fp8_f32(a4.z, a4.w, w, true);
                      *(LAS int*)(lds + SL_OFF + (64 * nb + 16 * ni + r) * SLS + 32 * mb + 16 * mi + 4 * g) = w;
                      acc[mi][ni] = a * dn; } } }
#pragma unroll
            for (int ks = 0; ks < 2; ++ks) {
                bf16x8 a[2], bb[4];
#pragma unroll
                for (int mi = 0; mi < 2; ++mi) a[mi] = *(const LAS bf16x8*)(lds + KH_OFF + (32 * mb + 16 * mi + r) * RS + (32 * ks + 8 * g) * 2);
#pragma unroll
                for (int ni = 0; ni < 4; ++ni) bb[ni] = *(const LAS bf16x8*)(lds + VT_OFF + (64 * nb + 16 * ni + r) * RS + (32 * ks + 8 * g) * 2);
#pragma unroll
                for (int mi = 0; mi < 2; ++mi)
#pragma unroll
                    for (int ni = 0; ni < 4; ++ni) acc[mi][ni] = MFMA16(a[mi], bb[ni], acc[mi][ni]);
            }
        }
        __syncthreads();
        HL_STORE_TILE(seg * 8 + 7);
        { bf16_t* ub = SEGS + (size_t)seg * (DK * DK);
#pragma unroll
          for (int mi = 0; mi < 2; ++mi)
#pragma unroll
              for (int ni = 0; ni < 4; ++ni) { const f32x4 a = acc[mi][ni]; u32x2 w;
                  w.x = bf_rne(a.x) | (bf_rne(a.y) << 16); w.y = bf_rne(a.z) | (bf_rne(a.w) << 16);
                  *(u32x2*)(ub + (size_t)(64 * nb + 16 * ni + r) * DK + 32 * mb + 16 * mi + 4 * g) = w; }
          if (e == 0) *(f32x2*)(SEGD + (size_t)seg * DK + 2 * lane) = v2exp2(cum); }
    }
#undef HL_STORE_TILE
    {
        unsigned char* Y = (unsigned char*)(ws + WS_Y);
        const float* cw = p.conv_w + (size_t)l * 3 * 512 + 8 * lane; const float* cg = p.conv_norm_g + (size_t)l * 512 + 8 * lane;
        float w0[8], w1[8], w2[8], gn[8];
#pragma unroll
        for (int i = 0; i < 8; ++i) { w0[i] = cw[i]; w1[i] = cw[512 + i]; w2[i] = cw[1024 + i]; gn[i] = cg[i]; }
        for (int run = cx.gw; run < NTOK / 8; run += cx.NGW) {
            const int t0 = run * 8; const bool first = (t0 & (SEQ - 1)) == 0;
            u32x4 uw[10], cb[8];
#pragma unroll
            for (int i = 0; i < 10; ++i) { const size_t t = (size_t)(first && i < 2 ? t0 : t0 - 2 + i);
                uw[i] = __builtin_nontemporal_load((const u32x4*)(PROJ + t * NPO + PC_U + 8 * lane)); }
#pragma unroll
            for (int i = 0; i < 8; ++i) cb[i] = __builtin_nontemporal_load((const u32x4*)(PROJ + (size_t)(t0 + i) * NPO + PC_CB + 8 * lane));
            float um2[8], um1[8];
#pragma unroll
            for (int q = 0; q < 4; ++q) { um2[2 * q] = first ? 0.f : bflo(uw[0][q]); um2[2 * q + 1] = first ? 0.f : bfhi(uw[0][q]);
                um1[2 * q] = first ? 0.f : bflo(uw[1][q]); um1[2 * q + 1] = first ? 0.f : bfhi(uw[1][q]); }
#pragma unroll
            for (int i = 0; i < 8; ++i) { const size_t t = (size_t)(t0 + i);
                float u[8], y[8], ss = 0.f;
#pragma unroll
                for (int q = 0; q < 4; ++q) { u[2 * q] = bflo(uw[i + 2][q]); u[2 * q + 1] = bfhi(uw[i + 2][q]); }
#pragma unroll
                for (int q = 0; q < 4; ++q) { y[2 * q] = bflo(cb[i][q]) * (w0[2 * q] * um2[2 * q] + w1[2 * q] * um1[2 * q] + w2[2 * q] * u[2 * q]);
                    y[2 * q + 1] = bfhi(cb[i][q]) * (w0[2 * q + 1] * um2[2 * q + 1] + w1[2 * q + 1] * um1[2 * q + 1] + w2[2 * q + 1] * u[2 * q + 1]); }
#pragma unroll
                for (int q = 0; q < 8; ++q) ss += y[q] * y[q];
                ss = oct_sum(ss);
                const float rstd = frsq(ss * (1.0f / 64.0f) + RMS_EPS);
                float o8[8];
#pragma unroll
                for (int q = 0; q < 8; ++q) o8[q] = y[q] * rstd * gn[q];
                *(u32x2*)(Y + t * D + 8 * lane) = pack8_fp8(o8);
#pragma unroll
                for (int q = 0; q < 8; ++q) { um2[q] = um1[q]; um1[q] = u[q]; }
            }
        }
    }
}

__device__ __forceinline__ void phase_hgrn_scan(const Params& p, LAS unsigned char* ldsb) {
    const Ctx cx = make_ctx(ldsb);
    unsigned char* ws = launder(p.ws);
    const bf16_t* SEGS = (const bf16_t*)(ws + WS_U); const float* SEGD = (const float*)(ws + WS_SEGD); const float* DEC = (const float*)(ws + WS_DEC); const unsigned char* ST = (const unsigned char*)(ws + WS_S); unsigned char* ST8 = (unsigned char*)(ws + WS_ST8);
    constexpr int NQ = NBATCH * NHEAD * DK * DK / 4, SCAN_T = 128;
    if (cx.tid >= SCAN_T) return;
    for (int q4 = cx.bid * SCAN_T + cx.tid; q4 < NQ; q4 += cx.G * SCAN_T) {
        const int eidx = 4 * q4, bh = eidx >> 14, rem = eidx & 16383, dk = rem & 127;
        const bf16_t* up = SEGS + (size_t)bh * 32 * (DK * DK) + rem; const float* dp = SEGD + (size_t)bh * 32 * DK + dk;
        const unsigned char* sp = ST + (size_t)bh * NCHUNK * (DK * DK) + rem; unsigned char* sq = ST8 + (size_t)bh * NCHUNK * (DK * DK) + rem; const float* pp = DEC + (size_t)bh * NCHUNK * DK + dk;
        f32x4 S = (f32x4){0.f, 0.f, 0.f, 0.f};
        for (int sg = 0; sg < 32; sg += 2) {
            u32x2 uw[2]; f32x4 d[2], pn[16]; unsigned sv[16];
#pragma unroll
            for (int i = 0; i < 2; ++i) { uw[i] = __builtin_nontemporal_load((const u32x2*)(up + (size_t)(sg + i) * (DK * DK))); d[i] = *(const f32x4*)(dp + (size_t)(sg + i) * DK); }
#pragma unroll
            for (int i = 0; i < 16; ++i) { sv[i] = __builtin_nontemporal_load((const unsigned*)(sp + (size_t)(sg * 8 + i) * (DK * DK))); pn[i] = *(const f32x4*)(pp + (size_t)(sg * 8 + i) * DK); }
#pragma unroll
            for (int i = 0; i < 2; ++i) {
#pragma unroll
                for (int j = 0; j < 8; ++j) { const int w = (int)sv[i * 8 + j];
                    const f32x2 lo = __builtin_amdgcn_cvt_pk_f32_fp8(w, false), hi = __builtin_amdgcn_cvt_pk_f32_fp8(w, true);
                    const f32x4 v = (f32x4){lo.x, lo.y, hi.x, hi.y} + pn[i * 8 + j] * S * ST8_SCALE;
                    int o = __builtin_amdgcn_cvt_pk_fp8_f32(v.x, v.y, 0, false); o = __builtin_amdgcn_cvt_pk_fp8_f32(v.z, v.w, o, true);
                    *(int*)(sq + (size_t)((sg + i) * 8 + j) * (DK * DK)) = o; }
                const f32x4 u = (f32x4){bflo(uw[i].x), bfhi(uw[i].x), bflo(uw[i].y), bfhi(uw[i].y)};
                S = d[i] * S + u; }
        }
    }
}

__device__ __forceinline__ void phase_hgrn_out(const Params& p, LAS unsigned char* ldsb, int l) {
    const Ctx cx = make_ctx(ldsb);
    unsigned char* ws = launder(p.ws);
    const bf16_t* PROJ = (const bf16_t*)(ws + WS_PROJ); const unsigned char* ST8 = (const unsigned char*)(ws + WS_ST8); unsigned char* Y = (unsigned char*)(ws + WS_Y);
    const float* LB = (const float*)(ws + WS_LB) + l * 512;
    constexpr int QH_OFF = 0, QT_OFF = 17408, KT_OFF = 34816, VT_OFF = 78336, P_OFF = 96768, TOT_OFF = 105984, QP_OFF = 110080, RQ = 272, RS = 144, OL_OFF = KT_OFF, OLS = 132;
    LAS unsigned char* lds = cx.lds; LAS float* tot = (LAS float*)(lds + TOT_OFF);
    const int e = cx.wave, lane = cx.lane, r = lane & 15, g = lane >> 4;
    for (int seg = cx.bid; seg < NUNIT / 8; seg += cx.G) {
        const int bh = seg >> 5, b = bh >> 2, h = bh & 3;
        const f32x2 lb = *(const f32x2*)(LB + 128 * h + 2 * lane);
        const f32x2 gnv = *(const f32x2*)(p.hgrn_norm_g + (size_t)l * 512 + 128 * h + 2 * lane);
        const bf16_t* base0 = PROJ + ((size_t)b * SEQ + (size_t)(seg & 31) * 8 * CHUNK + 8 * e) * NPO + 128 * h;
        const unsigned lvo = 4u * (unsigned)lane;
        unsigned fw[8], qw[8], vw[8];
        load_words8_nt(fw, base0 + PC_F, lvo); load_words8_nt(qw, base0 + PC_Q, lvo); load_words8_nt(vw, base0 + PC_I, lvo);
        const int it = e & 3, nb = e >> 2; f32x4 acc[4];
        for (int jc = 0; jc < 8; ++jc) {
        const int uid = seg * 8 + jc;
        const size_t row0 = (size_t)b * SEQ + (size_t)((seg & 31) * 8 + jc) * CHUNK;
        u32x4 sraw[4][2];
        { const unsigned char* sb = ST8 + (size_t)uid * (DK * DK);
#pragma unroll
          for (int ni = 0; ni < 4; ++ni)
#pragma unroll
              for (int hh = 0; hh < 2; ++hh) sraw[ni][hh] = __builtin_nontemporal_load((const u32x4*)(sb + (size_t)(64 * nb + 16 * ni + r) * DK + 32 * g + 16 * hh)); }
        f32x2 G[8], kf[8], pre[9];
        hgrn_gates(fw, lb, tot, e, lane, G, kf, pre);
        const int isub = e >> 1;
        f32x2 R[4];
#pragma unroll
        for (int i = 0; i < 4; ++i) R[i] = pre[2 * i];
        f32x2 Ri = (f32x2){0.f, 0.f};
#pragma unroll
        for (int i = 0; i < 4; ++i) if (i == isub) Ri = R[i];
        { const f32x2 eR = v2exp2(Ri);
#pragma unroll
          for (int j = 0; j < 8; ++j) { const f32x2 q = v2bf(qw[j]); const int t = 8 * e + j;
            const f32x2 sq = q * v2rcp(v2exp2(q * (-LOG2E)) + 1.0f);
            const f32x2 tq = sq * v2exp2(G[j] - Ri);
            *(LAS unsigned*)(lds + QT_OFF + t * RQ + 4 * lane) = pk2v(tq);
            *(LAS unsigned*)(lds + QH_OFF + t * RQ + 4 * lane) = pk2v(tq * eR); } }
        { f32x2 kd[8];
#pragma unroll
          for (int j = 0; j < 8; ++j) { f32x2 x = Ri - G[j]; x.x = fminf(x.x, 115.f); x.y = fminf(x.y, 115.f); kd[j] = kf[j] * v2exp2(x); }
#pragma unroll
          for (int i = 0; i < 4; ++i) if (i >= isub) { const f32x2 fc = v2exp2(R[i] - Ri);
#pragma unroll
              for (int j = 0; j < 8; ++j) { const int t = 8 * e + j;
                  *(LAS unsigned*)(lds + KT_OFF + (8 * i * (i + 1) + t) * RQ + 4 * lane) = pk2v(kd[j] * fc); } } }
        { u32x4 lo, hi; pack_t8(vw, lo, hi);
          *(LAS u32x4*)(lds + VT_OFF + (2 * lane) * RS + 16 * e) = lo; *(LAS u32x4*)(lds + VT_OFF + (2 * lane + 1) * RS + 16 * e) = hi; }
        if (jc < 7) { const bf16_t* bn = base0 + (size_t)(jc + 1) * CHUNK * NPO; load_words8_nt(fw, bn + PC_F, lvo); load_words8_nt(qw, bn + PC_Q, lvo); load_words8_nt(vw, bn + PC_I, lvo); }
        unsigned ogw[8];
        load_words8_nt(ogw, base0 + (size_t)jc * CHUNK * NPO + PC_OG, lvo);
        __syncthreads();
        { const int i = e >> 1;
#pragma unroll
          for (int jx = 0; jx < 2; ++jx) { const int j = 2 * (e & 1) + jx; f32x4 acc = (f32x4){0.f, 0.f, 0.f, 0.f};
              if (j <= i) {
#pragma unroll
                  for (int ks = 0; ks < 4; ++ks) { const bf16x8 a = *(const LAS bf16x8*)(lds + QT_OFF + (16 * i + r) * RQ + (32 * ks + 8 * g) * 2);
                      const bf16x8 bb = *(const LAS bf16x8*)(lds + KT_OFF + (8 * i * (i + 1) + 16 * j + r) * RQ + (32 * ks + 8 * g) * 2);
                      acc = MFMA16(a, bb, acc); } }
#pragma unroll
              for (int reg = 0; reg < 4; ++reg) { const int tl = 4 * g + reg; const float v = (j < i || (j == i && r <= tl)) ? acc[reg] : 0.f;
                  *(LAS bf16_t*)(lds + P_OFF + (16 * i + tl) * RS + (16 * j + r) * 2) = (bf16_t)f2bf(v); } } }
#pragma unroll
        for (int ni = 0; ni < 4; ++ni) acc[ni] = (f32x4){0.f, 0.f, 0.f, 0.f};
#pragma unroll
        for (int ks = 0; ks < 4; ++ks) { const bf16x8 a = *(const LAS bf16x8*)(lds + QH_OFF + (16 * it + r) * RQ + (32 * g + 8 * ks) * 2);
#pragma unroll
            for (int ni = 0; ni < 4; ++ni) { const u32x4 q4 = sraw[ni][ks >> 1]; const int w0 = (ks & 1) ? (int)q4.z : (int)q4.x, w1 = (ks & 1) ? (int)q4.w : (int)q4.y;
                u32x4 fb;
                fb.x = __builtin_bit_cast(unsigned, __builtin_amdgcn_cvt_scalef32_pk_bf16_fp8(w0, 1.0f / ST8_SCALE, false)); fb.y = __builtin_bit_cast(unsigned, __builtin_amdgcn_cvt_scalef32_pk_bf16_fp8(w0, 1.0f / ST8_SCALE, true));
                fb.z = __builtin_bit_cast(unsigned, __builtin_amdgcn_cvt_scalef32_pk_bf16_fp8(w1, 1.0f / ST8_SCALE, false)); fb.w = __builtin_bit_cast(unsigned, __builtin_amdgcn_cvt_scalef32_pk_bf16_fp8(w1, 1.0f / ST8_SCALE, true));
                acc[ni] = MFMA16(a, __builtin_bit_cast(bf16x8, fb), acc[ni]); } }
        __syncthreads();
        {
#pragma unroll
          for (int ks = 0; ks < 2; ++ks) { const bf16x8 a = *(const LAS bf16x8*)(lds + P_OFF + (16 * it + r) * RS + (32 * ks + 8 * g) * 2);
#pragma unroll
              for (int ni = 0; ni < 4; ++ni) { const bf16x8 bb = *(const LAS bf16x8*)(lds + VT_OFF + (64 * nb + 16 * ni + r) * RS + (32 * ks + 8 * g) * 2); acc[ni] = MFMA16(a, bb, acc[ni]); } }
#pragma unroll
          for (int ni = 0; ni < 4; ++ni)
#pragma unroll
              for (int reg = 0; reg < 4; ++reg) *(LAS float*)(lds + OL_OFF + ((16 * it + 4 * g + reg) * OLS + 64 * nb + 16 * ni + r) * 4) = acc[ni][reg];
        }
        __syncthreads();
        {
#pragma unroll
          for (int j = 0; j < 8; ++j) { const int t = 8 * e + j; const f32x2 o = *(const LAS f32x2*)(lds + OL_OFF + (t * OLS + 2 * lane) * 4);
              const float ss = wave_sum(o.x * o.x + o.y * o.y); const float rstd = frsq(ss * (1.0f / 128.0f) + RMS_EPS);
              const f32x2 og = v2bf(ogw[j]); const f32x2 y = o * rstd * gnv * (og * v2rcp(v2exp2(og * (-LOG2E)) + 1.0f));
              *(unsigned short*)(Y + (row0 + t) * D + 512 + 128 * h + 2 * lane) = (unsigned short)__builtin_amdgcn_cvt_pk_fp8_f32(y.x, y.y, 0, false); } }
        }
    }
}

__device__ __forceinline__ void phase_router(const Params& p, LAS unsigned char* ldsb, int l, int dummy = 0) {
    const Ctx cx = make_ctx(ldsb);
    unsigned char* ws = launder(p.ws);
    const bf16_t* X1 = (const bf16_t*)(ws + WS_X1); unsigned char* HN8 = (unsigned char*)(ws + WS_HN8);
    const float* ada = (const float*)(ws + WS_ADA) + (size_t)l * 2 * 6 * D;
    int* LISTA = (int*)(ws + WS_LISTA + (dummy ? ((size_t)64 << 20) : 0)); float* TOKGATE = (float*)(ws + WS_TOKGATE);
    unsigned* gcnt = (unsigned*)(ws + WS_CTL) + CW_CNT + 64 * (l + (dummy ? DEPTH : 0));
    LAS f32x4* wl = (LAS f32x4*)cx.lds;
    LAS int* lcnt = (LAS int*)(cx.lds + MISC_OFF + MS_LCNT); LAS int* gbase = (LAS int*)(cx.lds + MISC_OFF + MS_GBASE);
    const int lane = cx.lane, r = lane & 15, g = lane >> 4;
    const float* gn = p.norm2_g + (size_t)l * D;
    int cur_b = -1;
    for (int chunk = cx.bid; chunk < NTOK / 128; chunk += cx.G) {
        const int b = (chunk * 128) / SEQ;
        const float* sh = ada + (size_t)b * 6 * D + 3 * D; const float* sc = ada + (size_t)b * 6 * D + 4 * D;
        const int tok0 = chunk * 128 + cx.wave * 16;
        const bf16_t* xp = X1 + (size_t)(tok0 + r) * D + 8 * g;
        u32x4 xwa[16], xwb[16];
#pragma unroll
        for (int u = 0; u < 16; ++u) xwa[u] = *(const u32x4*)(xp + 32 * u);
        if (b != cur_b) {
            __syncthreads();
            const f32x4* WLG = (const f32x4*)(ws + WS_WL) + ((size_t)l * 2 + b) * 8192;
            f32x4 wv[16];
#pragma unroll
            for (int i = 0; i < 16; ++i) wv[i] = WLG[cx.tid + 512 * i];
#pragma unroll
            for (int i = 0; i < 16; ++i) wl[cx.tid + 512 * i] = wv[i];
            cur_b = b;
        }
        if (cx.tid < NE) lcnt[cx.tid] = 0;
        __syncthreads();
        f32x4 acc0 = (f32x4){0.f, 0.f, 0.f, 0.f}, acc1 = (f32x4){0.f, 0.f, 0.f, 0.f}; float ss = 0.f;
        { const LAS bf16x8* wlb = (const LAS bf16x8*)cx.lds;
#pragma unroll
          for (int u = 0; u < 16; ++u) xwb[u] = *(const u32x4*)(xp + 32 * (16 + u));
#pragma unroll
          for (int hb = 0; hb < 2; ++hb)
#pragma unroll
              for (int u = 0; u < 16; ++u) { const u32x4 xq = hb == 0 ? xwa[u] : xwb[u]; float xv[8]; unpack8(xq, xv);
#pragma unroll
                  for (int i = 0; i < 8; ++i) ss += xv[i] * xv[i];
                  const bf16x8 xa = __builtin_bit_cast(bf16x8, xq); const int fb = (16 * hb + u) * 256 + lane;
                  acc0 = MFMA16(xa, wlb[fb], acc0); acc1 = MFMA16(xa, wlb[fb + 128], acc1);
                  acc0 = MFMA16(xa, wlb[fb + 64], acc0); acc1 = MFMA16(xa, wlb[fb + 192], acc1); } }
        ss += __shfl_xor(ss, 16); ss += __shfl_xor(ss, 32);
        const float rstd = frsq(ss * (1.0f / D) + RMS_EPS);
        const float* RB = (const float*)(ws + WS_RB) + ((size_t)l * 2 + b) * NE; const float rb0 = RB[r], rb1 = RB[16 + r];
        int es = 0; float gs = 0.f;
#pragma unroll
        for (int reg = 0; reg < 4; ++reg) {
            const float rs = __shfl(rstd, 4 * g + reg);
            float v0 = acc0[reg] * rs + rb0, v1 = acc1[reg] * rs + rb1;
            float tv[4]; int ti[4];
#pragma unroll
            for (int k = 0; k < 4; ++k) { const bool up = v1 > v0; float bv = up ? v1 : v0; int bi = up ? 16 + r : r;
#define RT_STEP(CTRL) do { const float ov = dpp_f<CTRL>(bv); const int oi = dpp_i<CTRL>(bi); const bool take = ov > bv || (ov == bv && oi < bi); bv = take ? ov : bv; bi = take ? oi : bi; } while (0)
                RT_STEP(0xB1); RT_STEP(0x4E); RT_STEP(0x141); RT_STEP(0x140);
#undef RT_STEP
                tv[k] = bv; ti[k] = bi; v0 = (bi == r) ? -3.0e38f : v0; v1 = (bi == 16 + r) ? -3.0e38f : v1; }
            const float e1 = __expf(tv[1] - tv[0]), e2 = __expf(tv[2] - tv[0]), e3 = __expf(tv[3] - tv[0]); const float inv = 1.0f / (1.0f + e1 + e2 + e3);
            if ((r >> 2) == reg) { const int k = r & 3; es = k == 0 ? ti[0] : k == 1 ? ti[1] : k == 2 ? ti[2] : ti[3]; gs = (k == 0 ? 1.0f : k == 1 ? e1 : k == 2 ? e2 : e3) * inv; }
        }
        const int lp = __hip_atomic_fetch_add(lcnt + es, 1, __ATOMIC_RELAXED, __HIP_MEMORY_SCOPE_WORKGROUP);
        __syncthreads();
        unsigned gb = 0u; if (cx.tid < NE) gb = atomicAdd(gcnt + cx.tid, (unsigned)lcnt[cx.tid]);
        { float a8[2][8], s8[2][8];
#pragma unroll
          for (int j = 0; j < 2; ++j)
#pragma unroll
              for (int h = 0; h < 2; ++h) { const int c = 8 * lane + 512 * j + 4 * h; const f32x4 gg4 = *(const f32x4*)(gn + c), sc4 = *(const f32x4*)(sc + c), sh4 = *(const f32x4*)(sh + c);
#pragma unroll
                  for (int i = 0; i < 4; ++i) { a8[j][4 * h + i] = gg4[i] * (sc4[i] + 1.0f); s8[j][4 * h + i] = sh4[i]; } }
          for (int i0 = 0; i0 < 16; i0 += 4) { u32x4 xw[4][2];
#pragma unroll
              for (int u = 0; u < 4; ++u)
#pragma unroll
                  for (int j = 0; j < 2; ++j) xw[u][j] = *(const u32x4*)(X1 + (size_t)(tok0 + i0 + u) * D + 8 * lane + 512 * j);
#pragma unroll
              for (int u = 0; u < 4; ++u) { const float rs = __shfl(rstd, i0 + u);
#pragma unroll
                  for (int j = 0; j < 2; ++j) { float xv[8], o[8]; unpack8(xw[u][j], xv);
#pragma unroll
                      for (int i = 0; i < 8; ++i) o[i] = (xv[i] * rs) * a8[j][i] + s8[j][i];
                      *(u32x2*)(HN8 + (size_t)(tok0 + i0 + u) * D + 8 * lane + 512 * j) = pack8_fp8(o); } } } }
        if (cx.tid < NE) gbase[cx.tid] = (int)gb;
        __syncthreads();
        { const int pos = gbase[es] + lp; LISTA[(size_t)es * NASSIGN + pos] = chunk * 512 + cx.tid; TOKGATE[(size_t)chunk * 512 + cx.tid] = gs; }
    }
}

__device__ __forceinline__ void build_expert_tables(const Params& p, const Ctx& cx, int l) {
    const unsigned* gcnt = (const unsigned*)(launder(p.ws) + WS_CTL) + CW_CNT + 64 * l;
    LAS int* pstart = (LAS int*)(cx.lds + MISC_OFF + MS_PSTART); LAS int* cnt = (LAS int*)(cx.lds + MISC_OFF + MS_CNT);
    LAS unsigned char* blke = (LAS unsigned char*)(cx.lds + MISC_OFF + MS_BLKE); LAS int* nm = (LAS int*)(cx.lds + MISC_OFF + MS_NM);
    if (cx.tid < NE) cnt[cx.tid] = (int)gcnt[cx.tid];
    __syncthreads();
    if (cx.tid == 0) { int run = 0; for (int e = 0; e < NE; ++e) { pstart[e] = run; run += (cnt[e] + 255) & ~255; } pstart[NE] = run; nm[0] = run >> 8; }
    __syncthreads();
    if (cx.tid < NE) { const int b0 = pstart[cx.tid] >> 8, b1 = pstart[cx.tid + 1] >> 8; for (int b = b0; b < b1; ++b) blke[b] = (unsigned char)cx.tid; }
    __syncthreads();
}

__device__ __forceinline__ int bias_tab_off(int ui) { return ui < 16 ? BIAS_OFF + ui * 512 : IDX_OFF + 17 * 512 + (ui - 16) * 512; }
template <bool WANT_TOK, class Sched>
__device__ __forceinline__ bool build_row_tables(const Ctx& cx, const Sched& S, unsigned char* ws, const float* bias_l) {
    LAS int* pstart = (LAS int*)(cx.lds + MISC_OFF + MS_PSTART); LAS int* cnt = (LAS int*)(cx.lds + MISC_OFF + MS_CNT);
    LAS int* udesc = (LAS int*)(cx.lds + MISC_OFF + MS_LE);
    LAS int* nun = (LAS int*)(cx.lds + MISC_OFF + MS_LPOS);
    const int* LISTA = (const int*)(ws + WS_LISTA);
    constexpr int MU = WANT_TOK ? MAXU : MAXU / 2;
    if (cx.tid < MAXU) { pg8::Unit u; int base = 0, nv = -1, ue = 0, upn = 0;
        if (S.next(cx.tid, u)) { const int pos0 = (u.pm - (pstart[u.e] >> 8)) * 256; base = u.e * NASSIGN + pos0; nv = cnt[u.e] - pos0; nv = nv > 256 ? 256 : nv; ue = u.e; upn = u.pn; }
        udesc[4 * cx.tid] = base; udesc[4 * cx.tid + 1] = nv; udesc[4 * cx.tid + 2] = ue; udesc[4 * cx.tid + 3] = upn; }
    if (cx.tid == 0) { pg8::Unit u; nun[0] = S.next(WANT_TOK ? 17 : MU, u) ? 1 : 0; }
    __syncthreads();
    const bool ok = nun[0] == 0;
    const int r = cx.tid & 255, u0 = cx.tid >> 8;
    int v[MU / 2]; float bvv[MU / 2];
#pragma unroll
    for (int k = 0; k < MU / 2; ++k) { const int ui = 2 * k + u0, nv = udesc[4 * ui + 1], ue = udesc[4 * ui + 2], upn = udesc[4 * ui + 3];
        v[k] = (nv >= 0 && r < nv) ? LISTA[udesc[4 * ui] + r] : -1;
        bvv[k] = nv >= 0 ? (WANT_TOK ? bias_l[(size_t)ue * 2048 + (r < 128 ? 128 * upn + r : 1024 + 128 * upn + (r - 128))] : bias_l[(size_t)ue * D + 256 * upn + r]) : 0.f; }
#pragma unroll
    for (int k = 0; k < MU / 2; ++k) { const int ui = 2 * k + u0;
        if (udesc[4 * ui + 1] >= 0) {
            if (WANT_TOK) ((LAS unsigned short*)(cx.lds + IDX_OFF))[ui * 256 + r] = (unsigned short)(v[k] >= 0 ? (v[k] >> 2) : NTOK);
            else ((LAS int*)(cx.lds + IDX_OFF))[ui * 256 + r] = v[k];
            *(LAS bf16_t*)(cx.lds + bias_tab_off(ui) + 2 * r) = (bf16_t)f2bf(bvv[k]); } }
    __syncthreads();
    return ok;
}

constexpr int CROWS = 4;
__device__ __forceinline__ void phase_combine(const Params& p, LAS unsigned char* ldsb, int l, bool poison) {
    const Ctx cx = make_ctx(ldsb);
    unsigned char* ws = launder(p.ws);
    const bf16_t* X1 = (const bf16_t*)(ws + WS_X1); bf16_t* X0 = (bf16_t*)(ws + WS_X0); const unsigned char* SLOT = (const unsigned char*)(ws + WS_SLOT); bf16_t* HN = (bf16_t*)(ws + WS_HN);
    const float* TOKGATE = (const float*)(ws + WS_TOKGATE);
    const float* ada = (const float*)(ws + WS_ADA) + (size_t)l * 2 * 6 * D;
    const float* adan = (const float*)(ws + WS_ADA) + (size_t)(l + 1) * 2 * 6 * D;
    const int lane = cx.lane;
    for (int row0 = CROWS * cx.gw; row0 < NTOK; row0 += CROWS * cx.NGW) {
        const int b = row0 / SEQ; const float* g2 = ada + (size_t)b * 6 * D + 5 * D;
        u32x4 xw[CROWS][2]; u32x2 sw[CROWS][2][4];
        f32x4 gt[CROWS];
#pragma unroll
        for (int u = 0; u < CROWS; ++u) gt[u] = *(const f32x4*)(TOKGATE + (size_t)(row0 + u) * 4);
#pragma unroll
        for (int u = 0; u < CROWS; ++u)
#pragma unroll
            for (int j = 0; j < 2; ++j) { const int c = 8 * lane + 512 * j;
                xw[u][j] = __builtin_nontemporal_load((const u32x4*)(X1 + (size_t)(row0 + u) * D + c));
#pragma unroll
                for (int k = 0; k < 4; ++k) sw[u][j][k] = __builtin_nontemporal_load((const u32x2*)(SLOT + ((size_t)(row0 + u) * 4 + k) * D + c)); }
#pragma unroll
        for (int u = 0; u < CROWS; ++u) { const int row = row0 + u; float v[2][8];
#pragma unroll
            for (int j = 0; j < 2; ++j) { const int c = 8 * lane + 512 * j; float m[8], x[8];
#pragma unroll
                for (int i = 0; i < 8; ++i) m[i] = 0.f;
#pragma unroll
                for (int k = 0; k < 4; ++k) { float sv[8]; unpack8_fp8(sw[u][j][k], sv); const float gk = gt[u][k];
#pragma unroll
                    for (int i = 0; i < 8; ++i) m[i] += sv[i] * gk; }
                unpack8(xw[u][j], x);
                const f32x4 ga = *(const f32x4*)(g2 + c), gb = *(const f32x4*)(g2 + c + 4);
#pragma unroll
                for (int i = 0; i < 4; ++i) { v[j][i] = x[i] + ga[i] * m[i]; v[j][4 + i] = x[4 + i] + gb[i] * m[4 + i]; } }
            if (l < DEPTH - 1) {
#pragma unroll
                for (int j = 0; j < 2; ++j) *(u32x4*)(X0 + (size_t)row * D + 8 * lane + 512 * j) = pack8(v[j]);
                norm_mod_store8(v, p.norm1_g + (size_t)(l + 1) * D, adan + (size_t)b * 6 * D + 0 * D, adan + (size_t)b * 6 * D + 1 * D, HN + (size_t)row * D, lane);
            } else {
                float ss = 0.f;
#pragma unroll
                for (int j = 0; j < 2; ++j)
#pragma unroll
                    for (int i = 0; i < 8; ++i) ss += v[j][i] * v[j][i];
                const float rstd = frsq(wave_sum(ss) * (1.0f / D) + RMS_EPS);
#pragma unroll
                for (int j = 0; j < 2; ++j)
#pragma unroll
                    for (int h = 0; h < 2; ++h) { const int c = 8 * lane + 512 * j + 4 * h; const f32x4 fg = *(const f32x4*)(p.final_g + c);
                        f32x4 o = (f32x4){v[j][4 * h] * rstd * fg[0], v[j][4 * h + 1] * rstd * fg[1], v[j][4 * h + 2] * rstd * fg[2], v[j][4 * h + 3] * rstd * fg[3]};
                        if (poison) { const float q = __builtin_nanf(""); o = (f32x4){q, q, q, q}; }
                        *(f32x4*)(p.out + (size_t)row * D + c) = o; }
            }
        }
    }
}

constexpr int NPH = 2 + 9 * DEPTH;
__global__ void __launch_bounds__(512, 2) mk_fwd(Params p) {
    extern __shared__ __attribute__((aligned(16))) unsigned char lds_raw[];
    LAS unsigned char* const ldsb = (LAS unsigned char*)lds_raw;
    volatile LAS unsigned* barst = (volatile LAS unsigned*)(ldsb + MISC_OFF + MS_BAR);
    if (threadIdx.x < 4) barst[threadIdx.x] = 0u;
    __syncthreads();
    const int lo = p.ph_lo, hi = p.ph_hi;
    unsigned* barw = (unsigned*)(p.ws + WS_CTL) + CW_BAR;
    XcdBarrier bar; bar.bar = barw; bar.x = 0; bar.st = barst;
    if (hi - lo > 1) bar = xcd_barrier_post(barw, barst);
#define IN(k) (lo <= (k) && (k) < hi)
#define SEAM(k) do { if (IN(k) && IN((k) + 1)) xcd_barrier(bar); } while (0)

    if (IN(0)) for (int rep = 0; rep < REPS(0); ++rep) phase_prologue(p, ldsb);
    SEAM(0);
    if (IN(1)) for (int rep = 0; rep < REPS(1); ++rep) phase_norm1_first(p, ldsb);
    SEAM(1);
    for (int l = 0; l < DEPTH; ++l) {
        const int base = 2 + 9 * l;
        if (IN(base + 0)) for (int rep = 0; rep < REPS(2); ++rep) {
            const Ctx cx = make_ctx(ldsb); unsigned char* ws = launder(p.ws);
            pg8::Gemm g{(const bf16_t*)(ws + WS_HN), (const bf16_t*)(ws + WS_WIN) + (size_t)l * NPROJ * D, NTOK, NPROJ, D, 0};
            pg8::StaticOrder S; S.init(NTOK / 256, NPROJ, cx.G, cx.bid);
            pg8::EpiProj E{(bf16_t*)(ws + WS_PROJ)};
            const bool conv_first = ((cx.bid >> 3) & 1) != 0;
            if (conv_first && rep == 0) convert_expert_weights(p, cx, ws, l, 0);
            pg8::gemm_phase<pg8::EpiProj, pg8::StaticOrder>(cx.lds, g, S, E, cx.tid);
            if (!conv_first && rep == 0) convert_expert_weights(p, cx, ws, l, 0);
            if (rep == 0) convert_tail(p, cx, ws, l, 0);
        }
        SEAM(base + 0);
        if (IN(base + 1)) for (int rep = 0; rep < REPS(3); ++rep) phase_hgrn_local(p, ldsb, l);
        SEAM(base + 1);
        if (IN(base + 2)) for (int rep = 0; rep < REPS(4); ++rep) phase_hgrn_scan(p, ldsb);
        SEAM(base + 2);
        if (IN(base + 3)) for (int rep = 0; rep < REPS(5); ++rep) phase_hgrn_out(p, ldsb, l);
        SEAM(base + 3);
        if (IN(base + 4)) for (int rep = 0; rep < REPS(6); ++rep) {
            const Ctx cx = make_ctx(ldsb); unsigned char* ws = launder(p.ws);
            const float* ada_l = (const float*)(ws + WS_ADA) + (size_t)l * 2 * 6 * D;
            pg8::Gemm g{(const bf16_t*)(ws + WS_Y), (const bf16_t*)(ws + WS_WOUT + (size_t)l * D * D), NTOK, D, D / 2, 0};
            pg8::StaticOrder S; S.init(NTOK / 256, D, cx.G, cx.bid);
            if (l == 0) { pg8::EpiResidual<true> E{(const void*)p.x, (bf16_t*)(ws + WS_X1), ada_l + 2 * D, 1.0f / WGU_SCALE};
                pg8::gemm_phase<pg8::EpiResidual<true>, pg8::StaticOrder, true, true>(cx.lds, g, S, E, cx.tid, nullptr); }
            else { pg8::EpiResidual<false> E{(const void*)(ws + WS_X0), (bf16_t*)(ws + WS_X1), ada_l + 2 * D, 1.0f / WGU_SCALE};
                pg8::gemm_phase<pg8::EpiResidual<false>, pg8::StaticOrder, true, true>(cx.lds, g, S, E, cx.tid, nullptr); }
        }
        SEAM(base + 4);
        if (IN(base + 5)) for (int rep = 0; rep < REPS(7); ++rep) phase_router(p, ldsb, l, rep);
        SEAM(base + 5);
        if (IN(base + 6)) for (int rep = 0; rep < REPS(9); ++rep) {
            const Ctx cx = make_ctx(ldsb); unsigned char* ws = launder(p.ws);
            build_expert_tables(p, cx, l);
            const int nmb = *(LAS int*)(cx.lds + MISC_OFF + MS_NM);
            pg8::Gemm g{(const bf16_t*)(ws + WS_HN8), (const bf16_t*)(ws + WS_WGU + (size_t)l * NE * 2048 * D), nmb * 256, 2048, D / 2, (size_t)2048 * D};
            pg8::GroupedOrder S; S.init(nmb, 2048, cx.G, cx.bid); S.blk_e = (const LAS unsigned char*)(cx.lds + MISC_OFF + MS_BLKE);
            const bool conv_first = ((cx.bid >> 3) & 1) != 0;
            const int r_hi = (nmb * 8) % cx.G;
            if (conv_first && rep == 0) convert_expert_weights(p, cx, ws, l, 1, r_hi);
            if (build_row_tables<true>(cx, S, ws, p.b_gu + (size_t)l * NE * 2048)) {
                pg8::EpiGateUp E{(unsigned char*)(ws + WS_ACT), (const LAS unsigned char*)cx.lds, 1.0f / WGU_SCALE};
                pg8::gemm_phase<pg8::EpiGateUp, pg8::GroupedOrder, true, true>(cx.lds, g, S, E, cx.tid, (const LAS unsigned short*)(cx.lds + IDX_OFF));
            }
            if (!conv_first && rep == 0) convert_expert_weights(p, cx, ws, l, 1, r_hi);
            if (rep == 0) convert_tail(p, cx, ws, l, 1);
        }
        SEAM(base + 6);
        if (IN(base + 7)) for (int rep = 0; rep < REPS(10); ++rep) {
            const Ctx cx = make_ctx(ldsb); unsigned char* ws = launder(p.ws);
            build_expert_tables(p, cx, l);
            const int nmb = *(LAS int*)(cx.lds + MISC_OFF + MS_NM);
            pg8::Gemm g{(const bf16_t*)(ws + WS_ACT), (const bf16_t*)(ws + WS_WDN + (size_t)l * NE * D * D), nmb * 256, D, D / 2, (size_t)D * D};
            pg8::GroupedOrder S; S.init(nmb, D, cx.G, cx.bid); S.blk_e = (const LAS unsigned char*)(cx.lds + MISC_OFF + MS_BLKE);
            if (build_row_tables<false>(cx, S, ws, p.b_down + (size_t)l * NE * D)) {
                pg8::EpiDown E{(unsigned char*)(ws + WS_SLOT), (const LAS unsigned char*)cx.lds, (const LAS int*)(cx.lds + IDX_OFF), 1.0f / WGU_SCALE};
                pg8::gemm_phase<pg8::EpiDown, pg8::GroupedOrder, true, true>(cx.lds, g, S, E, cx.tid, nullptr);
            }
        }
        SEAM(base + 7);
        if (IN(base + 8)) {
            const bool poison = (l == DEPTH - 1) && (__hip_atomic_load(barw + XB_TMO, __ATOMIC_RELAXED, __HIP_MEMORY_SCOPE_AGENT) != 0u);
            for (int rep = 0; rep < REPS(11); ++rep) phase_combine(p, ldsb, l, poison);
        }
        if (l < DEPTH - 1) SEAM(base + 8);
    }
#undef IN
#undef SEAM
}

extern "C" void kernel_launch(void* const* d_in, const int* in_sizes, int n_in, void* d_out, int out_size, void* d_ws, size_t ws_size, hipStream_t stream) {
    static int grid = 0;
    if (grid == 0) {
        if (n_in != 19 || in_sizes[0] != NTOK * D || out_size != NTOK * D || ws_size < WS_END) {
            fprintf(stderr, "kernel_launch: unexpected shapes (n_in %d, in0 %d, out %d, ws %zu need %zu); nothing launched\n", n_in, n_in > 0 ? in_sizes[0] : -1, out_size, ws_size, (size_t)WS_END); grid = -1; return; }
        int dev = 0, cus = 0, per_cu = 0;
        if (hipGetDevice(&dev) != hipSuccess || hipDeviceGetAttribute(&cus, hipDeviceAttributeMultiprocessorCount, dev) != hipSuccess) { fprintf(stderr, "kernel_launch: device query failed\n"); grid = -1; return; }
        if (hipFuncSetAttribute((const void*)mk_fwd, hipFuncAttributeMaxDynamicSharedMemorySize, LDS_BYTES) != hipSuccess) { fprintf(stderr, "kernel_launch: hipFuncSetAttribute failed\n"); grid = -1; return; }
        if (hipOccupancyMaxActiveBlocksPerMultiprocessor(&per_cu, (const void*)mk_fwd, 512, LDS_BYTES) != hipSuccess || per_cu < 1)
            fprintf(stderr, "kernel_launch: note: occupancy query reports %d workgroups per CU\n", per_cu);
        (void)hipGetLastError();
        grid = cus;
    }
    if (grid < 0) return;
    if (hipMemsetAsync((char*)d_ws + WS_CTL, 0, CTL_ZERO_BYTES, stream) != hipSuccess) { fprintf(stderr, "kernel_launch: memset failed\n"); return; }
    Params p{};
    p.x = (const float*)d_in[0]; p.c = (const float*)d_in[1]; p.w_ada = (const float*)d_in[2]; p.b_ada = (const float*)d_in[3]; p.norm1_g = (const float*)d_in[4]; p.norm2_g = (const float*)d_in[5];
    p.w_in = (const float*)d_in[6]; p.conv_w = (const float*)d_in[7]; p.conv_norm_g = (const float*)d_in[8]; p.lower_bounds = (const float*)d_in[9]; p.hgrn_norm_g = (const float*)d_in[10];
    p.w_out = (const float*)d_in[11]; p.w_router = (const float*)d_in[12]; p.b_router = (const float*)d_in[13]; p.w_gu = (const float*)d_in[14]; p.b_gu = (const float*)d_in[15];
    p.w_down = (const float*)d_in[16]; p.b_down = (const float*)d_in[17]; p.final_g = (const float*)d_in[18];
    p.out = (float*)d_out; p.ws = (unsigned char*)d_ws;
#if MK_SPLIT
    for (int k = 0; k < NPH; ++k) { p.ph_lo = k; p.ph_hi = k + 1; hipLaunchKernelGGL(mk_fwd, dim3(grid), dim3(512), LDS_BYTES, stream, p); }
#else
    p.ph_lo = 0; p.ph_hi = NPH;
    hipLaunchKernelGGL(mk_fwd, dim3(grid), dim3(512), LDS_BYTES, stream, p);
#endif
    const hipError_t le = hipPeekAtLastError();
    if (le != hipSuccess) fprintf(stderr, "kernel_launch: launch failed: %s\n", hipGetErrorName(le));
}
```
